# Optimizing an MI355X kernel written in HIP

```python
import math
import jax, jax.numpy as jnp
from jax import lax
import numpy as np

D_MODEL = 2048
BATCH = 1
SEQ = 8192
DEPTH = 2

HEAD_DIM = 128
N_HEADS_DIFF = 4
DIFF_QK_DIM = 64
DIFF_V_DIM = 2 * DIFF_QK_DIM
DIFF_LAMBDA_STD = 0.1
N_HEADS_FOX = 6
FOX_HEAD_DIM = HEAD_DIM
FORGET_BIAS_MIN = 1.0
FORGET_BIAS_MAX = 4.0
N_HEADS_MLA = 6
MLA_Q_RANK = 512
MLA_KV_RANK = 256
MLA_NOPE_DIM = 128
MLA_ROPE_DIM = 64
MLA_QK_DIM = MLA_ROPE_DIM + MLA_NOPE_DIM
MLA_V_DIM = 128
MIX_WIDTH = N_HEADS_DIFF * DIFF_V_DIM + N_HEADS_FOX * FOX_HEAD_DIM + N_HEADS_MLA * MLA_V_DIM
D_FF = 4 * D_MODEL
ROPE_THETA = 500000.0
PARTIAL_ROT_DIM = DIFF_QK_DIM // 4
BLOCK_Q = 128
EPS = 1e-6

DIFF_Q_COLS = N_HEADS_DIFF * 2 * DIFF_QK_DIM
DIFF_V_COLS = N_HEADS_DIFF * DIFF_V_DIM
FOX_COLS = N_HEADS_FOX * FOX_HEAD_DIM
MLA_KV_DOWN_COLS = MLA_KV_RANK + MLA_ROPE_DIM
IN_SECTIONS = (DIFF_Q_COLS, DIFF_Q_COLS, DIFF_V_COLS,
               FOX_COLS, FOX_COLS, FOX_COLS, N_HEADS_FOX,
               MLA_Q_RANK, MLA_KV_DOWN_COLS)
IN_COLS = 2 * DIFF_Q_COLS + DIFF_V_COLS + 3 * FOX_COLS + N_HEADS_FOX + MLA_Q_RANK + MLA_KV_DOWN_COLS

kernel_name = "hymba_style_diff_fox_mla_trunk"


def rms_norm(x, g):
    xf = x.astype(jnp.float32)
    y = xf * lax.rsqrt(jnp.mean(xf * xf, axis=-1, keepdims=True) + EPS)
    return (y * g.astype(jnp.float32)).astype(x.dtype)


def rope_tables(seq_len, rot_dim):
    half = rot_dim // 2
    inv_freq = ROPE_THETA ** (-jnp.arange(half, dtype=jnp.float32) / half)
    ang = jnp.arange(seq_len, dtype=jnp.float32)[:, None] * inv_freq[None, :]
    return jnp.cos(ang), jnp.sin(ang)


def apply_rope(x, cos, sin):
    half = cos.shape[-1]
    rot_dim = 2 * half
    c = cos[None, :, None, :]
    s = sin[None, :, None, :]
    xr = x[..., :rot_dim].astype(jnp.float32)
    x1, x2 = xr[..., :half], xr[..., half:]
    rotated = jnp.concatenate([x1 * c - x2 * s, x2 * c + x1 * s], axis=-1).astype(x.dtype)
    return jnp.concatenate([rotated, x[..., rot_dim:]], axis=-1)


def causal_block_attention(q, k, v, scale, log_decay_cum=None):
    b, s, h, dk = q.shape
    nb = s // BLOCK_Q
    q_blocks = jnp.moveaxis(q.reshape(b, nb, BLOCK_Q, h, dk), 1, 0)
    if log_decay_cum is None:
        c_blocks, c_keys = None, None
    else:
        c_blocks = jnp.moveaxis(log_decay_cum.reshape(b, nb, BLOCK_Q, h), 1, 0)
        c_keys = jnp.transpose(log_decay_cum, (0, 2, 1))[:, :, None, :]
    k_pos = jnp.arange(s)

    def attend(args):
        i, qi, ci = args
        logits = jnp.einsum("bqhd,bkhd->bhqk", qi, k, preferred_element_type=jnp.float32) * scale
        if ci is not None:
            logits = logits + jnp.transpose(ci, (0, 2, 1))[..., None] - c_keys
        q_pos = i * BLOCK_Q + jnp.arange(BLOCK_Q)
        logits = jnp.where(k_pos[None, :] <= q_pos[:, None], logits, -jnp.inf)
        p = jax.nn.softmax(logits, axis=-1).astype(v.dtype)
        return jnp.einsum("bhqk,bkhv->bqhv", p, v)

    out = lax.map(attend, (jnp.arange(nb), q_blocks, c_blocks))
    return jnp.moveaxis(out, 0, 1).reshape(b, s, h, v.shape[-1])


def diff_attention(q, k, v, cos, sin, q_norm, k_norm, lq1, lk1, lq2, lk2, subln, layer_idx):
    b, s, _ = q.shape
    q = rms_norm(q.reshape(b, s, 2 * N_HEADS_DIFF, DIFF_QK_DIM), q_norm)
    k = rms_norm(k.reshape(b, s, 2 * N_HEADS_DIFF, DIFF_QK_DIM), k_norm)
    q = apply_rope(q, cos, sin).reshape(b, s, N_HEADS_DIFF, 2, DIFF_QK_DIM)
    k = apply_rope(k, cos, sin).reshape(b, s, N_HEADS_DIFF, 2, DIFF_QK_DIM)
    v = v.reshape(b, s, N_HEADS_DIFF, DIFF_V_DIM)
    lambda_init = 0.8 - 0.6 * math.exp(-0.3 * layer_idx)
    lam = (jnp.exp(jnp.sum(lq1.astype(jnp.float32) * lk1.astype(jnp.float32)))
           - jnp.exp(jnp.sum(lq2.astype(jnp.float32) * lk2.astype(jnp.float32)))
           + lambda_init)
    scale = DIFF_QK_DIM ** -0.5
    o1 = causal_block_attention(q[:, :, :, 0], k[:, :, :, 0], v, scale)
    o2 = causal_block_attention(q[:, :, :, 1], k[:, :, :, 1], v, scale)
    o = o1.astype(jnp.float32) - lam * o2.astype(jnp.float32)
    o = rms_norm(o, subln) * (1.0 - lambda_init)
    return o.reshape(b, s, N_HEADS_DIFF * DIFF_V_DIM).astype(v.dtype)


def forgetting_attention(q, k, v, f_logit, f_bias, q_norm, k_norm):
    b, s, _ = q.shape
    q = rms_norm(q.reshape(b, s, N_HEADS_FOX, FOX_HEAD_DIM), q_norm)
    k = rms_norm(k.reshape(b, s, N_HEADS_FOX, FOX_HEAD_DIM), k_norm)
    v = v.reshape(b, s, N_HEADS_FOX, FOX_HEAD_DIM)
    log_f = jax.nn.log_sigmoid(f_logit.astype(jnp.float32) + f_bias.astype(jnp.float32))
    cum = jnp.cumsum(log_f, axis=1)
    o = causal_block_attention(q, k, v, FOX_HEAD_DIM ** -0.5, cum)
    return o.reshape(b, s, N_HEADS_FOX * FOX_HEAD_DIM)


def latent_attention(q_down, kv_down, cos, sin, q_a_norm, kv_a_norm, w_q_up, w_kv_up, q_norm, k_norm):
    b, s, _ = q_down.shape
    q = (rms_norm(q_down, q_a_norm) @ w_q_up).reshape(b, s, N_HEADS_MLA, MLA_QK_DIM)
    c_kv = rms_norm(kv_down[..., :MLA_KV_RANK], kv_a_norm)
    k_rope = kv_down[..., MLA_KV_RANK:].reshape(b, s, 1, MLA_ROPE_DIM)
    kv = (c_kv @ w_kv_up).reshape(b, s, N_HEADS_MLA, MLA_NOPE_DIM + MLA_V_DIM)
    k_nope, v = kv[..., :MLA_NOPE_DIM], kv[..., MLA_NOPE_DIM:]
    q_rope = apply_rope(rms_norm(q[..., :MLA_ROPE_DIM], q_norm[:MLA_ROPE_DIM]), cos, sin)
    q_nope = rms_norm(q[..., MLA_ROPE_DIM:], q_norm[MLA_ROPE_DIM:])
    k_rope = apply_rope(rms_norm(k_rope, k_norm[:MLA_ROPE_DIM]), cos, sin)
    k_nope = rms_norm(k_nope, k_norm[MLA_ROPE_DIM:])
    q = jnp.concatenate([q_rope, q_nope], axis=-1)
    k = jnp.concatenate([jnp.broadcast_to(k_rope, (b, s, N_HEADS_MLA, MLA_ROPE_DIM)), k_nope], axis=-1)
    o = causal_block_attention(q, k, v, MLA_QK_DIM ** -0.5)
    return o.reshape(b, s, N_HEADS_MLA * MLA_V_DIM)


def split_columns(proj):
    parts, start = [], 0
    for width in IN_SECTIONS:
        parts.append(proj[..., start:start + width])
        start += width
    return parts


def setup_inputs(seed: int = 0) -> dict:
    key = jax.random.key(seed)
    ks = jax.random.split(key, 24)

    def normal(k, shape, scale):
        return scale * jax.random.normal(k, shape, jnp.float32)

    def gain(k, dim):
        return 1.0 + normal(k, (DEPTH, dim), 0.05)

    L = DEPTH
    return {
        "x": normal(ks[0], (BATCH, SEQ, D_MODEL), 1.0),
        "norm_mix": gain(ks[1], D_MODEL),
        "w_in": normal(ks[2], (L, D_MODEL, IN_COLS), D_MODEL ** -0.5),
        "diff_q_norm": gain(ks[3], DIFF_QK_DIM),
        "diff_k_norm": gain(ks[4], DIFF_QK_DIM),
        "diff_lambda_q1": normal(ks[5], (L, DIFF_QK_DIM), DIFF_LAMBDA_STD),
        "diff_lambda_k1": normal(ks[6], (L, DIFF_QK_DIM), DIFF_LAMBDA_STD),
        "diff_lambda_q2": normal(ks[7], (L, DIFF_QK_DIM), DIFF_LAMBDA_STD),
        "diff_lambda_k2": normal(ks[8], (L, DIFF_QK_DIM), DIFF_LAMBDA_STD),
        "diff_subln": gain(ks[9], DIFF_V_DIM),
        "fox_q_norm": gain(ks[10], FOX_HEAD_DIM),
        "fox_k_norm": gain(ks[11], FOX_HEAD_DIM),
        "fox_forget_bias": jax.random.uniform(ks[12], (L, N_HEADS_FOX), jnp.float32,
                                              FORGET_BIAS_MIN, FORGET_BIAS_MAX),
        "mla_q_a_norm": gain(ks[13], MLA_Q_RANK),
        "mla_kv_a_norm": gain(ks[14], MLA_KV_RANK),
        "mla_w_q_up": normal(ks[15], (L, MLA_Q_RANK, N_HEADS_MLA * MLA_QK_DIM), MLA_Q_RANK ** -0.5),
        "mla_w_kv_up": normal(ks[16], (L, MLA_KV_RANK, N_HEADS_MLA * (MLA_NOPE_DIM + MLA_V_DIM)),
                              MLA_KV_RANK ** -0.5),
        "mla_q_norm": gain(ks[17], MLA_QK_DIM),
        "mla_k_norm": gain(ks[18], MLA_QK_DIM),
        "w_out": normal(ks[19], (L, MIX_WIDTH, D_MODEL), MIX_WIDTH ** -0.5),
        "norm_ffn": gain(ks[20], D_MODEL),
        "w_ff_up": normal(ks[21], (L, D_MODEL, D_FF), D_MODEL ** -0.5),
        "w_ff_down": normal(ks[22], (L, D_FF, D_MODEL), D_FF ** -0.5),
    }


def reference(x, norm_mix, w_in, diff_q_norm, diff_k_norm, diff_lambda_q1, diff_lambda_k1,
              diff_lambda_q2, diff_lambda_k2, diff_subln, fox_q_norm, fox_k_norm, fox_forget_bias,
              mla_q_a_norm, mla_kv_a_norm, mla_w_q_up, mla_w_kv_up, mla_q_norm, mla_k_norm,
              w_out, norm_ffn, w_ff_up, w_ff_down):
    seq = x.shape[1]
    cos_p, sin_p = rope_tables(seq, PARTIAL_ROT_DIM)
    cos_m, sin_m = rope_tables(seq, MLA_ROPE_DIM)
    for l in range(DEPTH):
        h = rms_norm(x, norm_mix[l])
        proj = h @ w_in[l]
        dq, dk, dv, fq, fk, fv, ff, mq, mkv = split_columns(proj)
        o_a = diff_attention(dq, dk, dv, cos_p, sin_p, diff_q_norm[l], diff_k_norm[l],
                             diff_lambda_q1[l], diff_lambda_k1[l], diff_lambda_q2[l],
                             diff_lambda_k2[l], diff_subln[l], l)
        o_b = forgetting_attention(fq, fk, fv, ff, fox_forget_bias[l], fox_q_norm[l], fox_k_norm[l])
        o_c = latent_attention(mq, mkv, cos_m, sin_m, mla_q_a_norm[l], mla_kv_a_norm[l],
                               mla_w_q_up[l], mla_w_kv_up[l], mla_q_norm[l], mla_k_norm[l])
        mixed = jnp.concatenate([o_a, o_b.astype(o_a.dtype), o_c.astype(o_a.dtype)], axis=-1)
        x = x + (mixed @ w_out[l]).astype(x.dtype)
        h = rms_norm(x, norm_ffn[l])
        x = x + (jnp.square(jax.nn.relu(h @ w_ff_up[l])) @ w_ff_down[l]).astype(x.dtype)
    return x
```

```cpp
#include <hip/hip_runtime.h>
#include <hip/hip_cooperative_groups.h>
#include <cstdio>
#include <cstdint>
namespace cg = cooperative_groups;
constexpr float RMS_EPS = 1e-6f;
namespace pg8 {
#define PG8_LAS __attribute__((address_space(3)))
typedef unsigned short bf16_t;
typedef short bf16x8 __attribute__((ext_vector_type(8)));
typedef float f32x4 __attribute__((ext_vector_type(4)));
typedef unsigned u32x4 __attribute__((ext_vector_type(4)));
constexpr int BM = 256, BK = 64, HALF = 128, HTB = HALF * BK * 2  , STAGE_BYTES = 8 * HTB, NXCD = 8, WGM = 2;

__host__ __device__ __forceinline__ int lds_byte(int r, int c) { const int st = (r >> 4) * 2 + (c >> 5), rr = r & 15, cc = c & 31, ob = rr * 64 + cc * 2; return st * 1024 + (ob ^ (((ob >> 9) & 1) << 5)); }
__host__ __device__ __forceinline__ void stage_rc(int b, int& R, int& C) { const int st = b / 1024, sb = b % 1024, swz = sb ^ (((sb >> 9) & 1) << 5); R = (st >> 1) * 16 + swz / 64; C = (st & 1) * 32 + (swz % 64) / 2; }
__host__ __device__ __forceinline__ int perm32(int rho) { const int n = rho >> 4, i = rho & 15; return 8 * (i >> 2) + 4 * n + (i & 3); }

struct Unit { int pm, pn; };
struct Gemm { const bf16_t* A; const bf16_t* Bt; int M, N, K, lda; };

struct StaticOrder {
    int nM, nN, nwg, G, c;
    __host__ __device__ void init(int M, int N, int G_, int c_) { nM = M / BM; nN = N / BM; nwg = nM * nN; G = G_; c = c_; }
    __host__ __device__ bool next(int i, Unit& u) const {
        const long L = (long)i * G + c; if (L >= nwg) return false;
        int wgid = (int)L; { const int q = nwg / NXCD, r = nwg % NXCD, xcd = wgid % NXCD, off = wgid / NXCD; wgid = (xcd < r ? xcd * (q + 1) : r * (q + 1) + (xcd - r) * q) + off; }
        const int nig = WGM * nN, gid = wgid / nig, fm = gid * WGM, gsz = (nM - fm) < WGM ? (nM - fm) : WGM;
        u.pm = fm + ((wgid % nig) % gsz); u.pn = (wgid % nig) / gsz; return true;
    }
    __device__ __forceinline__ void a_ready(const Unit&) const {}
    __device__ __forceinline__ void done(const Unit&) const {}
};

typedef float cvt2_f32x2 __attribute__((ext_vector_type(2))); typedef __bf16 cvt2_bf16x2 __attribute__((ext_vector_type(2)));
__device__ __forceinline__ unsigned cvt_pk_bf16(float lo, float hi) { const cvt2_f32x2 v = {lo, hi}; const cvt2_bf16x2 r = __builtin_convertvector(v, cvt2_bf16x2); return __builtin_bit_cast(unsigned, r); }


template <bool RELU2> struct EpiScaleBf16 {
    static constexpr bool PERM = true, AFTER_DRAIN = false;
    bf16_t* O; int ldc; const float* ssq;
    __device__ __forceinline__ void operator()(const f32x4 (&acc)[2][2][4][2], const Unit& u, int wr, int wc, int fr, int fq) const {
        const int row0 = u.pm * BM + wr * 64 + fr, col0 = u.pn * BM + wc * 32 + 8 * fq;
#pragma unroll
        for (int ai = 0; ai < 2; ++ai)
#pragma unroll
            for (int m = 0; m < 4; ++m) {
                const int row = row0 + ai * HALF + m * 16;
                const float rs = ssq ? rsqrtf(ssq[row] * (1.0f / 2048.0f) + RMS_EPS) : 1.0f;
                bf16_t* rowp = O + (size_t)row * ldc + col0;
#pragma unroll
                for (int bj = 0; bj < 2; ++bj) {
                    f32x4 v0 = acc[ai][bj][m][0] * rs, v1 = acc[ai][bj][m][1] * rs;
                    if (RELU2) {
#pragma unroll
                        for (int e = 0; e < 4; ++e) { float a = fmaxf(v0[e], 0.f), b = fmaxf(v1[e], 0.f); v0[e] = a * a; v1[e] = b * b; }
                    }
                    u32x4 w; w.x = cvt_pk_bf16(v0[0], v0[1]); w.y = cvt_pk_bf16(v0[2], v0[3]); w.z = cvt_pk_bf16(v1[0], v1[1]); w.w = cvt_pk_bf16(v1[2], v1[3]);
                    *(u32x4*)(rowp + bj * HALF) = w;
                }
            }
    }
};
struct EpiResid {
    static constexpr bool PERM = false, AFTER_DRAIN = false;
    const float* base; float* out; bf16_t* xb; float* ssq;
    __device__ __forceinline__ void operator()(const f32x4 (&acc)[2][2][4][2], const Unit& u, int wr, int wc, int fr, int fq) const {
        typedef unsigned u32x2 __attribute__((ext_vector_type(2)));
        const int row0 = u.pm * BM + wr * 64 + fr, col0 = u.pn * BM + wc * 32 + 4 * fq;
#pragma unroll
        for (int ai = 0; ai < 2; ++ai)
#pragma unroll
            for (int m = 0; m < 4; ++m) {
                const int row = row0 + ai * HALF + m * 16;
                const size_t off = (size_t)row * 2048 + col0;
                float s = 0.f;
#pragma unroll
                for (int bj = 0; bj < 2; ++bj)
#pragma unroll
                    for (int n = 0; n < 2; ++n) {
                        const f32x4 b = *(const f32x4*)(base + off + bj * HALF + n * 16);
                        const f32x4 v = b + acc[ai][bj][m][n];
                        *(f32x4*)(out + off + bj * HALF + n * 16) = v;
                        if (xb) { u32x2 w; w.x = cvt_pk_bf16(v[0], v[1]); w.y = cvt_pk_bf16(v[2], v[3]); *(u32x2*)(xb + off + bj * HALF + n * 16) = w; }
                        s += (v[0] * v[0] + v[1] * v[1]) + (v[2] * v[2] + v[3] * v[3]);
                    }
                if (ssq) { s += __shfl_xor(s, 16); s += __shfl_xor(s, 32); if (fq == 0) unsafeAtomicAdd(ssq + row, s); }
            }
    }
};
template <class Epi, class Sched, bool ALIGN_EPI = false, bool SP2 = false>
__device__ __forceinline__ void gemm_phase(PG8_LAS unsigned char* lds, const Gemm g, const Sched& S, const Epi& E) {
    int tid_ = threadIdx.x; asm volatile("" : "+v"(tid_));
    const int tid = tid_, wid = __builtin_amdgcn_readfirstlane(tid >> 6), lane = tid & 63, wr = wid >> 2, wc = wid & 3, fr = lane & 15, fq = lane >> 4;
    const int K = g.K, nt = K / BK;
    unsigned voffA[2], voffB[2];
#pragma unroll
    for (int i = 0; i < 2; ++i) { int R, C; stage_rc(tid * 16 + i * 8192, R, C); const int Rb = Epi::PERM ? ((R & ~31) + perm32(R & 31)) : R;
        voffA[i] = (unsigned)(R * g.lda + C) * 2u; voffB[i] = (unsigned)(Rb * K + C) * 2u; }
    const size_t kstep = (size_t)(BK * 2);
    const size_t hstepA = (size_t)HALF * g.lda * 2, hstepB = (size_t)HALF * K * 2;
    const size_t tstepA = 2 * hstepA, tstepB = 2 * hstepB;
    const unsigned ldsw = (unsigned)wid * 1024u;
    const int aoff = lds_byte(wr * 64 + fr, fq * 8), boff = lds_byte(wc * 32 + fr, fq * 8);
#define PG8_SA(b, h) (((b) * 2 + (h)) * HTB)
#define PG8_SB(b, h) ((4 + (b) * 2 + (h)) * HTB)
#define PG8_STAGE(bufoff, gbase, voff) do { _Pragma("unroll") for (int _i = 0; _i < 2; ++_i) \
        __builtin_amdgcn_global_load_lds((const unsigned*)((const char*)(gbase) + (voff)[_i]), (PG8_LAS unsigned*)(lds + (bufoff) + ldsw + _i * 8192), 16, 0, 0); } while (0)
#define PG8_LDA(dst, b, h) do { _Pragma("unroll") for (int m = 0; m < 4; ++m) _Pragma("unroll") for (int k = 0; k < 2; ++k) dst[m][k] = *(const PG8_LAS bf16x8*)(lds + PG8_SA(b, h) + aoff + m * 2048 + k * 1024); } while (0)
#define PG8_LDB(dst, b, h) do { _Pragma("unroll") for (int n = 0; n < 2; ++n) _Pragma("unroll") for (int k = 0; k < 2; ++k) dst[n][k] = *(const PG8_LAS bf16x8*)(lds + PG8_SB(b, h) + boff + n * 2048 + k * 1024); } while (0)
#define PG8_MMA(ai, bj, At, Bt) do { __builtin_amdgcn_s_setprio(1); _Pragma("unroll") for (int m = 0; m < 4; ++m) _Pragma("unroll") for (int n = 0; n < 2; ++n) _Pragma("unroll") for (int k = 0; k < 2; ++k) \
        acc[ai][bj][m][n] = __builtin_amdgcn_mfma_f32_16x16x32_bf16(Bt[n][k], At[m][k], acc[ai][bj][m][n], 0, 0, 0); __builtin_amdgcn_s_setprio(0); } while (0)
#define PG8_WAIT_V(n) asm volatile("s_waitcnt vmcnt(" #n ")" ::: "memory")
#define PG8_WAIT_L(n) asm volatile("s_waitcnt lgkmcnt(" #n ")" ::: "memory")
#define PG8_BAR __builtin_amdgcn_s_barrier()
#define PG8_SCHED __builtin_amdgcn_sched_barrier(0)
    Unit cur, nxt; int ui = 0;
    if (!S.next(0, cur)) return;
    f32x4 acc[2][2][4][2];
#pragma unroll
    for (int a = 0; a < 2; ++a)
#pragma unroll
        for (int b = 0; b < 2; ++b)
#pragma unroll
            for (int m = 0; m < 4; ++m)
#pragma unroll
                for (int n = 0; n < 2; ++n) acc[a][b][m][n] = (f32x4){0.f, 0.f, 0.f, 0.f};
    bf16x8 At[4][2], B0[2][2], B1[2][2];
    const char* cA = (const char*)g.A + (size_t)cur.pm * tstepA; const char* cB = (const char*)g.Bt + (size_t)cur.pn * tstepB;
    S.a_ready(cur);
    if constexpr (SP2) {
        PG8_STAGE(PG8_SB(0, 0), cB, voffB); PG8_STAGE(PG8_SB(0, 1), cB + hstepB, voffB); PG8_STAGE(PG8_SA(0, 0), cA, voffA); PG8_STAGE(PG8_SA(0, 1), cA + hstepA, voffA);
        if (wr == 1) PG8_BAR;
        PG8_WAIT_V(2); PG8_BAR;
        PG8_STAGE(PG8_SB(1, 0), cB + kstep, voffB); PG8_STAGE(PG8_SA(1, 0), cA + kstep, voffA); PG8_STAGE(PG8_SB(1, 1), cB + hstepB + kstep, voffB);
        PG8_WAIT_V(6); PG8_BAR;
    } else {
        PG8_STAGE(PG8_SB(0, 0), cB, voffB); PG8_STAGE(PG8_SA(0, 0), cA, voffA); PG8_STAGE(PG8_SB(0, 1), cB + hstepB, voffB); PG8_STAGE(PG8_SA(0, 1), cA + hstepA, voffA);
        if (wr == 1) PG8_BAR;
        PG8_WAIT_V(4); PG8_BAR;
        PG8_STAGE(PG8_SB(1, 0), cB + kstep, voffB); PG8_STAGE(PG8_SA(1, 0), cA + kstep, voffA); PG8_STAGE(PG8_SB(1, 1), cB + hstepB + kstep, voffB);
        PG8_WAIT_V(6); PG8_BAR;
    }
    for (;;) {
        const bool has_next = S.next(ui + 1, nxt);
        const char* nA = has_next ? (const char*)g.A + (size_t)nxt.pm * tstepA : cA; const char* nB = has_next ? (const char*)g.Bt + (size_t)nxt.pn * tstepB : cB;
        for (int t = 0; t < nt; t += 2) {
            const bool last = (t == nt - 2);
            const char* a1 = cA + (size_t)(t + 1) * kstep;
            const char* a2 = last ? nA : cA + (size_t)(t + 2) * kstep; const char* b2 = last ? nB : cB + (size_t)(t + 2) * kstep;
            const char* a3 = a2 + kstep; const char* b3 = b2 + kstep;
            if (last && has_next) S.a_ready(nxt);
            if constexpr (SP2) {
            PG8_LDB(B0, 0, 0); PG8_LDB(B1, 0, 1); PG8_SCHED; PG8_LDA(At, 0, 0); PG8_STAGE(PG8_SA(1, 1), a1 + hstepA, voffA);
            PG8_WAIT_V(8); PG8_WAIT_L(0); PG8_BAR; PG8_MMA(0, 0, At, B0); PG8_MMA(0, 1, At, B1); PG8_BAR; PG8_SCHED;
            PG8_LDA(At, 0, 1); PG8_STAGE(PG8_SB(0, 0), b2, voffB); PG8_STAGE(PG8_SB(0, 1), b2 + hstepB, voffB); PG8_STAGE(PG8_SA(0, 0), a2, voffA);
            PG8_WAIT_V(8); PG8_WAIT_L(0); PG8_BAR; PG8_MMA(1, 0, At, B0); PG8_MMA(1, 1, At, B1); PG8_BAR; PG8_SCHED;
            PG8_LDB(B0, 1, 0); PG8_LDB(B1, 1, 1); PG8_SCHED; PG8_LDA(At, 1, 0); PG8_STAGE(PG8_SA(0, 1), a2 + hstepA, voffA);
            PG8_WAIT_V(8); PG8_WAIT_L(0); PG8_BAR; PG8_MMA(0, 0, At, B0); PG8_MMA(0, 1, At, B1); PG8_BAR; PG8_SCHED;
            PG8_LDA(At, 1, 1); PG8_STAGE(PG8_SB(1, 0), b3, voffB); PG8_STAGE(PG8_SB(1, 1), b3 + hstepB, voffB); PG8_STAGE(PG8_SA(1, 0), a3, voffA);
            PG8_WAIT_V(8); PG8_WAIT_L(0); PG8_BAR; PG8_MMA(1, 0, At, B0); PG8_MMA(1, 1, At, B1); PG8_BAR; PG8_SCHED;
            } else {
            PG8_LDB(B0, 0, 0); PG8_SCHED; PG8_LDA(At, 0, 0); PG8_STAGE(PG8_SA(1, 1), a1 + hstepA, voffA);
            PG8_WAIT_L(8); PG8_BAR; PG8_WAIT_L(0); PG8_MMA(0, 0, At, B0); PG8_BAR; PG8_SCHED;
            PG8_LDB(B1, 0, 1); PG8_STAGE(PG8_SB(0, 0), b2, voffB);
            PG8_BAR; PG8_WAIT_L(0); PG8_MMA(0, 1, At, B1); PG8_BAR;
            PG8_LDA(At, 0, 1); PG8_STAGE(PG8_SA(0, 0), a2, voffA);
            PG8_BAR; PG8_WAIT_L(0); PG8_MMA(1, 0, At, B0); PG8_BAR; PG8_SCHED;
            PG8_STAGE(PG8_SB(0, 1), b2 + hstepB, voffB);
            PG8_WAIT_V(6); PG8_BAR; PG8_MMA(1, 1, At, B1); PG8_BAR;
            PG8_LDB(B0, 1, 0); PG8_SCHED; PG8_LDA(At, 1, 0); PG8_STAGE(PG8_SA(0, 1), a2 + hstepA, voffA);
            PG8_WAIT_L(8); PG8_BAR; PG8_WAIT_L(0); PG8_MMA(0, 0, At, B0); PG8_BAR; PG8_SCHED;
            PG8_LDB(B1, 1, 1); PG8_STAGE(PG8_SB(1, 0), b3, voffB);
            PG8_BAR; PG8_WAIT_L(0); PG8_MMA(0, 1, At, B1); PG8_BAR;
            PG8_LDA(At, 1, 1); PG8_STAGE(PG8_SA(1, 0), a3, voffA);
            PG8_BAR; PG8_WAIT_L(0); PG8_MMA(1, 0, At, B0); PG8_BAR; PG8_SCHED;
            PG8_STAGE(PG8_SB(1, 1), b3 + hstepB, voffB);
            PG8_WAIT_V(6); PG8_BAR; PG8_MMA(1, 1, At, B1); PG8_BAR;
            }
        }
        if constexpr (ALIGN_EPI) { if (wr == 0) PG8_BAR; }
        if constexpr (!Epi::AFTER_DRAIN) { E(acc, cur, wr, wc, fr, fq); S.done(cur); }
        if (!has_next) break;
#pragma unroll
        for (int a = 0; a < 2; ++a)
#pragma unroll
            for (int b = 0; b < 2; ++b)
#pragma unroll
                for (int m = 0; m < 4; ++m)
#pragma unroll
                    for (int n = 0; n < 2; ++n) acc[a][b][m][n] = (f32x4){0.f, 0.f, 0.f, 0.f};
        cur = nxt; cA = nA; cB = nB; ++ui;
        if constexpr (ALIGN_EPI) { if (wr == 1) PG8_BAR; }
    }
    PG8_WAIT_V(0);
    if constexpr (!ALIGN_EPI) { if (wr == 0) PG8_BAR; }
    PG8_BAR;
    if constexpr (Epi::AFTER_DRAIN) { E.fused(acc, cur, wr, wc, fr, fq, lds, wid, lane); S.done(cur); }
#undef PG8_SA
#undef PG8_SB
#undef PG8_STAGE
#undef PG8_LDA
#undef PG8_LDB
#undef PG8_MMA
#undef PG8_WAIT_V
#undef PG8_WAIT_L
#undef PG8_BAR
#undef PG8_SCHED
}
}

#define LAS __attribute__((address_space(3)))
typedef unsigned short bf16_t;
typedef short bf16x8 __attribute__((ext_vector_type(8)));
typedef short s16x4 __attribute__((ext_vector_type(4)));
typedef float f32x4 __attribute__((ext_vector_type(4)));
typedef float f32x16 __attribute__((ext_vector_type(16)));
typedef unsigned u32x4 __attribute__((ext_vector_type(4)));
typedef unsigned u32x2 __attribute__((ext_vector_type(2)));
typedef float f32x2 __attribute__((ext_vector_type(2)));

constexpr int SEQ = 8192, DM = 2048, DFF = 8192, NIN = 4678, NINP = 4864, NQUP = 1152, NQUPP = 1280, NKVUP = 1536;
constexpr int C_DQ = 0, C_DK = 512, C_DV = 1024, C_FQ = 1536, C_FK = 2304, C_FV = 3072, C_MQ = 3840, C_CKV = 4352, C_KR = 4608, C_FF = 4672;
constexpr size_t MiB = 1u << 20;
constexpr size_t WS_CNT = 0, WS_LAM = 128, WS_TABLE = 4096, WS_BAR = 16384, WS_SSQ = 64 * 1024, WS_LOGF = 256 * 1024, WS_CUM = 512 * 1024;
constexpr size_t WS_COSP = 1 * MiB, WS_SINP = 1 * MiB + 256 * 1024, WS_COSM = 2 * MiB, WS_SINM = 3 * MiB;
constexpr size_t WS_WIN = 4 * MiB, SZ_WIN = 19 * MiB, WS_WOUT = 42 * MiB, SZ_WOUT = 8 * MiB, WS_WUP = 58 * MiB, SZ_WUP = 32 * MiB, WS_WDN = 122 * MiB, SZ_WDN = 32 * MiB;
constexpr size_t WS_WQUP = 186 * MiB, SZ_WQUP = (size_t)NQUPP * 512 * 2, WS_WKVUP = 189 * MiB, SZ_WKVUP = (size_t)NKVUP * 256 * 2;
constexpr size_t WS_XB = 192 * MiB, WS_XF = 224 * MiB, WS_MIX = 288 * MiB, WS_PROJ = 320 * MiB, WS_QC = 396 * MiB, WS_KVC = 416 * MiB, WS_H = 320 * MiB, WS_END = 448 * MiB;
#ifndef ATT_SPLIT
#define ATT_SPLIT 0
#endif
constexpr int NUNITS = ATT_SPLIT ? 1024 : 640;
constexpr int LDS_BYTES = 131072 + 4096;
constexpr float LOG2E = 1.4426950408889634f;

struct Args {
    const float* in[23];
    float* out; unsigned char* ws;
    int ph_lo, ph_hi;
};
typedef const __attribute__((address_space(4))) Args* ArgsP;
enum { I_X = 0, I_NORM_MIX, I_W_IN, I_DQN, I_DKN, I_LQ1, I_LK1, I_LQ2, I_LK2, I_SUBLN, I_FQN, I_FKN, I_FBIAS, I_QAN, I_KVAN, I_WQUP, I_WKVUP, I_MQN, I_MKN, I_WOUT, I_NORM_FFN, I_WUP, I_WDN };

typedef float cvt_f32x2 __attribute__((ext_vector_type(2))); typedef __bf16 cvt_bf16x2 __attribute__((ext_vector_type(2)));
__device__ __forceinline__ unsigned cvtpk(float lo, float hi) { const cvt_f32x2 v = {lo, hi}; const cvt_bf16x2 r = __builtin_convertvector(v, cvt_bf16x2); return __builtin_bit_cast(unsigned, r); }
__device__ __forceinline__ float bflo(unsigned w) { return __uint_as_float(w << 16); }
__device__ __forceinline__ float bfhi(unsigned w) { return __uint_as_float(w & 0xffff0000u); }
__device__ __forceinline__ float wave_sum(float v) {
#pragma unroll
    for (int o = 1; o < 64; o <<= 1) v += __shfl_xor(v, o);
    return v;
}

#define XB_TMO      128
#define XB_XCNT(j)  (256  + 64 * (j))
#define XB_XSUB(j)  (1280 + 64 * (j))
#define XB_XGEN(j)  (2304 + 64 * (j))
#define XB_TOP      3328
#define XB_TOPGEN   3392
#define XCD_BAR_WORDS 3456
#define XB_SPIN_CAP (1u << 18)

__device__ __forceinline__ unsigned xb_ld(unsigned* p)              { return __hip_atomic_load(p, __ATOMIC_RELAXED, __HIP_MEMORY_SCOPE_AGENT); }
__device__ __forceinline__ unsigned xb_add(unsigned* p, unsigned v) { return __hip_atomic_fetch_add(p, v, __ATOMIC_RELAXED, __HIP_MEMORY_SCOPE_AGENT); }
__device__ __forceinline__ unsigned xb_xcc_id() { return (unsigned)__builtin_amdgcn_s_getreg((3 << 11) | 20) & 0xFu; }
#define XB_SPIN(cond, bar) do { unsigned _sp = 0; while (cond) { __builtin_amdgcn_s_sleep(1); \
    if ((++_sp & 255u) == 0u) { if (xb_ld(&(bar)[XB_TMO])) break; if (_sp > XB_SPIN_CAP) { atomicAdd(&(bar)[XB_TMO], 1u); break; } } } } while (0)

struct XcdBarrier {
    unsigned* bar; unsigned x;
    volatile LAS unsigned* st;
};

__device__ __forceinline__ XcdBarrier xcd_barrier_post(unsigned* bar, volatile LAS unsigned* st) {
    XcdBarrier b; b.bar = bar; b.x = xb_xcc_id(); b.st = st;
    if (threadIdx.x == 0) (void)xb_add(&bar[XB_XCNT(b.x)], 1u);
    return b;
}
__device__ __forceinline__ void xcd_barrier_complete(unsigned* bar, unsigned x, unsigned& nloc, unsigned& nx) {
    const unsigned G = gridDim.x * gridDim.y * gridDim.z;
    unsigned sum, cnt, mine, sp = 0u;
    for (;;) {
        sum = 0u; cnt = 0u; mine = 0u;
#pragma unroll
        for (unsigned j = 0; j < 16; ++j) { const unsigned c = xb_ld(&bar[XB_XCNT(j)]); sum += c; cnt += (c > 0u) ? 1u : 0u; mine = (j == x) ? c : mine; }
        if (sum == G) break;
        __builtin_amdgcn_s_sleep(1);
        if ((++sp & 255u) == 0u) { if (xb_ld(&bar[XB_TMO])) break; if (sp > XB_SPIN_CAP) { atomicAdd(&bar[XB_TMO], 1u); break; } }
    }
    nloc = mine > 0u ? mine : 1u; nx = cnt > 0u ? cnt : 1u;
}

__device__ __forceinline__ void xcd_barrier(const XcdBarrier& b) {
    asm volatile("s_waitcnt vmcnt(0)" ::: "memory");
    __syncthreads();
    if (threadIdx.x == 0) {
        unsigned* bar = b.bar;
        __builtin_amdgcn_s_waitcnt(0);
        unsigned nloc = b.st[0], nx = b.st[1];
        if (nloc == 0u) { xcd_barrier_complete(bar, b.x, nloc, nx); b.st[0] = nloc; b.st[1] = nx; }
        const unsigned old = xb_add(&bar[XB_XSUB(b.x)], 1u);
        const unsigned gen = old / nloc;
        if (old + 1u == (gen + 1u) * nloc) {
            __builtin_amdgcn_fence(__ATOMIC_RELEASE, "agent");
            asm volatile("s_waitcnt vmcnt(0)" ::: "memory");
            const unsigned og = xb_add(&bar[XB_TOP], 1u);
            const unsigned tg = og / nx;
            if (og + 1u == (tg + 1u) * nx) xb_add(&bar[XB_TOPGEN], 1u);
            else XB_SPIN(xb_ld(&bar[XB_TOPGEN]) == tg, bar);
            __builtin_amdgcn_fence(__ATOMIC_ACQUIRE, "agent");
            xb_add(&bar[XB_XGEN(b.x)], 1u);
            asm volatile("s_waitcnt vmcnt(0)" ::: "memory");
        } else {
            XB_SPIN(xb_ld(&bar[XB_XGEN(b.x)]) == gen, bar);
            __builtin_amdgcn_fence(__ATOMIC_ACQUIRE, "agent");
            asm volatile("s_waitcnt vmcnt(0)" ::: "memory");
        }
    }
    __syncthreads();
}


template <int MAP>
__device__ __forceinline__ void tr_item(const float* __restrict__ W, int K, int N, const float* __restrict__ gain, bf16_t* WT, LAS float* scr, int item, int lane) {
    const int nblk = (N + 31) / 32, kb = item / nblk, nb = item % nblk, k0 = 64 * kb, n0 = 32 * nb;
    const int nsrc = n0 + (lane & 31); const bool ok = nsrc < N;
    float v[32];
#pragma unroll
    for (int i = 0; i < 32; ++i) { const int kk = 2 * i + (lane >> 5); v[i] = ok ? __builtin_nontemporal_load(W + (size_t)(k0 + kk) * N + nsrc) : 0.f; }
#pragma unroll
    for (int i = 0; i < 32; ++i) { const int kk = 2 * i + (lane >> 5); float x = v[i]; if (gain) x *= gain[k0 + kk]; scr[kk * 33 + (lane & 31)] = x; }
    asm volatile("s_waitcnt lgkmcnt(0)" ::: "memory");
    const int c = lane & 7;
#pragma unroll
    for (int j = 0; j < 4; ++j) {
        const int nl = (lane >> 3) + 8 * j, n = n0 + nl;
        const LAS float* s = scr + (8 * c) * 33 + nl;
        u32x4 o; o.x = cvtpk(s[0 * 33], s[1 * 33]); o.y = cvtpk(s[2 * 33], s[3 * 33]); o.z = cvtpk(s[4 * 33], s[5 * 33]); o.w = cvtpk(s[6 * 33], s[7 * 33]);
        int dest = n;
        if (MAP == 1) { if (n >= 3846) dest = n - 6; else if (n >= 3840) dest = C_FF + (n - 3840); }
        if (n < N) *(u32x4*)(WT + (size_t)dest * K + k0 + 8 * c) = o;
    }
    asm volatile("s_waitcnt lgkmcnt(0)" ::: "memory");
}

constexpr int TR_IT_IN = (DM / 64) * ((NIN + 31) / 32), TR_IT_OUT = (DM / 64) * (DM / 32), TR_IT_UP = (DM / 64) * (DFF / 32), TR_IT_DN = (DFF / 64) * (DM / 32);
constexpr int TR_IT_QUP = (512 / 64) * (NQUP / 32), TR_IT_KVUP = (256 / 64) * (NKVUP / 32);
constexpr int TR_PER_L = TR_IT_IN + TR_IT_OUT + TR_IT_UP + TR_IT_DN + TR_IT_QUP + TR_IT_KVUP;
constexpr int TR_CHUNK = 16;
constexpr int TR_N_EARLY = TR_IT_IN + TR_IT_QUP + TR_IT_KVUP, TR_N_LATE = TR_IT_OUT + TR_IT_UP + TR_IT_DN;
__device__ __forceinline__ int tr_early_item(int i) { return i < TR_IT_IN ? i : i + TR_N_LATE; }
__device__ __forceinline__ int tr_late_item(int i) { return i + TR_IT_IN; }
__device__ __forceinline__ void tr_dispatch(ArgsP a, int l, int r, LAS float* scr, int lane) {
    unsigned char* ws = a->ws;
    if (r < TR_IT_IN) { tr_item<1>(a->in[I_W_IN] + (size_t)l * DM * NIN, DM, NIN, a->in[I_NORM_MIX] + l * DM, (bf16_t*)(ws + WS_WIN + l * SZ_WIN), scr, r, lane); return; } r -= TR_IT_IN;
    if (r < TR_IT_OUT) { tr_item<0>(a->in[I_WOUT] + (size_t)l * DM * DM, DM, DM, nullptr, (bf16_t*)(ws + WS_WOUT + l * SZ_WOUT), scr, r, lane); return; } r -= TR_IT_OUT;
    if (r < TR_IT_UP) { tr_item<0>(a->in[I_WUP] + (size_t)l * DM * DFF, DM, DFF, a->in[I_NORM_FFN] + l * DM, (bf16_t*)(ws + WS_WUP + l * SZ_WUP), scr, r, lane); return; } r -= TR_IT_UP;
    if (r < TR_IT_DN) { tr_item<0>(a->in[I_WDN] + (size_t)l * DFF * DM, DFF, DM, nullptr, (bf16_t*)(ws + WS_WDN + l * SZ_WDN), scr, r, lane); return; } r -= TR_IT_DN;
    if (r < TR_IT_QUP) { tr_item<0>(a->in[I_WQUP] + (size_t)l * 512 * NQUP, 512, NQUP, a->in[I_QAN] + l * 512, (bf16_t*)(ws + WS_WQUP + l * SZ_WQUP), scr, r, lane); return; } r -= TR_IT_QUP;
    tr_item<0>(a->in[I_WKVUP] + (size_t)l * 256 * NKVUP, 256, NKVUP, a->in[I_KVAN] + l * 256, (bf16_t*)(ws + WS_WKVUP + l * SZ_WKVUP), scr, r, lane);
}
__device__ __forceinline__ void prologue(ArgsP a, LAS unsigned char* lds) {
    int tid_ = threadIdx.x; asm volatile("" : "+v"(tid_));
    const int tid = tid_, lane = tid & 63, wave = __builtin_amdgcn_readfirstlane(tid >> 6);
    const int G = gridDim.x, gw = blockIdx.x * 8 + wave, NGW = G * 8;
    unsigned char* ws = a->ws;
    if (blockIdx.x == 0) {
        if (tid < 32) ((int*)(ws + WS_CNT))[tid] = 0;
        if (tid >= 64 && tid < 66) {
            const int l = tid - 64; float s1 = 0.f, s2 = 0.f;
            for (int i = 0; i < 64; ++i) { s1 += a->in[I_LQ1][l * 64 + i] * a->in[I_LK1][l * 64 + i]; s2 += a->in[I_LQ2][l * 64 + i] * a->in[I_LK2][l * 64 + i]; }
            const float linit = 0.8f - 0.6f * expf(-0.3f * (float)l);
            ((float*)(ws + WS_LAM))[l] = expf(s1) - expf(s2) + linit;
        }
        if (tid >= 66 && tid < 68) {
            const int l = tid - 66; float gq = 0.f, gk = 0.f;
            for (int i = 0; i < 128; ++i) { gq = fmaxf(gq, fabsf(a->in[I_FQN][l * 128 + i])); gk = fmaxf(gk, fabsf(a->in[I_FKN][l * 128 + i])); }
            ((float*)(ws + WS_LAM))[8 + l] = 11.3137085f * gq * gk * 1.4426950408889634f * 1.02f;
        }
        if (tid >= 68 && tid < 70) {
            const int l = tid - 68; float gq = 0.f, gk = 0.f, qr_ = 0.f, qn = 0.f, kr = 0.f, kn = 0.f;
            for (int i = 0; i < 64; ++i) { gq = fmaxf(gq, fabsf(a->in[I_DQN][l * 64 + i])); gk = fmaxf(gk, fabsf(a->in[I_DKN][l * 64 + i])); }
            ((float*)(ws + WS_LAM))[12 + l] = 8.0f * gq * gk * 1.4426950408889634f * 1.02f;
            for (int i = 0; i < 64; ++i) { qr_ = fmaxf(qr_, fabsf(a->in[I_MQN][l * 192 + i])); kr = fmaxf(kr, fabsf(a->in[I_MKN][l * 192 + i])); }
            for (int i = 64; i < 192; ++i) { qn = fmaxf(qn, fabsf(a->in[I_MQN][l * 192 + i])); kn = fmaxf(kn, fabsf(a->in[I_MKN][l * 192 + i])); }
            ((float*)(ws + WS_LAM))[16 + l] = sqrtf(64.f * qr_ * qr_ + 128.f * qn * qn) * sqrtf(64.f * kr * kr + 128.f * kn * kn) * 0.07216878364870322f * 1.4426950408889634f * 1.02f;
        }
        for (int id = tid; id < NUNITS; id += 512) {
            auto cost = [](int u) { constexpr int Q = ATT_SPLIT ? 64 : 32, NB = 256 + 6 * Q;
                                    return u < 256 ? 48 * ((u & 63) + 1) : (u < NB ? (ATT_SPLIT ? 16 : 64) * (((u - 256) % Q) + 1) : (ATT_SPLIT ? 40 : 160) * (((u - NB) % Q) + 1)); };
            const int mine = cost(id); int rank = 0;
            for (int j = 0; j < NUNITS; ++j) { const int cj = cost(j); rank += (cj > mine || (cj == mine && j < id)) ? 1 : 0; }
            ((int*)(ws + WS_TABLE))[rank] = id;
        }
    }
    {
        LAS float* invf = (LAS float*)(lds + 80 * 1024);
        if (tid < 8) invf[tid] = (float)pow(500000.0, -(double)tid / 8.0);
        else if (tid < 40) invf[tid] = (float)pow(500000.0, -(double)(tid - 8) / 32.0);
        __syncthreads();
        float* cosp = (float*)(ws + WS_COSP); float* sinp = (float*)(ws + WS_SINP); float* cosm = (float*)(ws + WS_COSM); float* sinm = (float*)(ws + WS_SINM);
        const int gt = blockIdx.x * 512 + tid, NT = G * 512;
        for (int i = gt; i < SEQ * 40; i += NT) {
            const int pos = i / 40, j = i % 40;
            const float ang = (float)pos * invf[j]; const float c = (float)cos((double)ang), s = (float)sin((double)ang);
            if (j < 8) { cosp[pos * 8 + j] = c; sinp[pos * 8 + j] = s; } else { cosm[pos * 32 + j - 8] = c; sinm[pos * 32 + j - 8] = s; }
        }
    }
    {
        const float* x = a->in[I_X]; bf16_t* xb = (bf16_t*)(ws + WS_XB); float* ssq = (float*)(ws + WS_SSQ);
        for (int m = gw; m < SEQ; m += NGW) {
            const f32x4* xr = (const f32x4*)(x + (size_t)m * DM) + lane; u32x2* o = (u32x2*)(xb + (size_t)m * DM) + lane; float s = 0.f;
#pragma unroll
            for (int j = 0; j < 8; ++j) { const f32x4 v = xr[64 * j]; s += (v[0] * v[0] + v[1] * v[1]) + (v[2] * v[2] + v[3] * v[3]); u32x2 w; w.x = cvtpk(v[0], v[1]); w.y = cvtpk(v[2], v[3]); o[64 * j] = w; }
            s = wave_sum(s);
            if (lane == 0) ssq[m] = s;
            if (lane >= 1 && lane < 4) ssq[lane * SEQ + m] = 0.f;
        }
    }
    {
        LAS float* scr = (LAS float*)(lds + wave * 8704);
        for (int it = gw; it < TR_N_EARLY; it += NGW) tr_dispatch(a, 0, tr_early_item(it), scr, lane);
    }
}

__device__ __forceinline__ void unpack8(const u32x4 w, float* f) { f[0] = bflo(w.x); f[1] = bfhi(w.x); f[2] = bflo(w.y); f[3] = bfhi(w.y); f[4] = bflo(w.z); f[5] = bfhi(w.z); f[6] = bflo(w.w); f[7] = bfhi(w.w); }
__device__ __forceinline__ u32x4 pack8f(const float* f) { u32x4 w; w.x = cvtpk(f[0], f[1]); w.y = cvtpk(f[2], f[3]); w.z = cvtpk(f[4], f[5]); w.w = cvtpk(f[6], f[7]); return w; }

__device__ __forceinline__ void post_proj_row(ArgsP a, int l, int row, int lane) {
    unsigned char* ws = a->ws;
    bf16_t* P = (bf16_t*)(ws + WS_PROJ) + (size_t)row * NINP;
    const u32x4 ld_d0 = *(const u32x4*)(P + 16 * lane), ld_d1 = *(const u32x4*)(P + 16 * lane + 8);
    const u32x4 ld_f0 = *(const u32x4*)(P + C_FQ + 8 * lane), ld_f1 = *(const u32x4*)(P + C_FQ + 512 + 8 * lane), ld_f2 = *(const u32x4*)(P + C_FQ + 1024 + 8 * lane);
    const u32x4 ld_q = *(const u32x4*)(P + C_MQ + 8 * lane);
    const u32x2 ld_c = *(const u32x2*)(P + C_CKV + 4 * lane);
    const u32x4 ld_k = *(const u32x4*)(P + C_KR + 8 * (lane & 7));
    const unsigned short ld_ff = P[C_FF + (lane < 6 ? lane : 0)];
    {
        float x[16]; unpack8(ld_d0, x); unpack8(ld_d1, x + 8);
        float ss = 0.f;
#pragma unroll
        for (int i = 0; i < 16; ++i) ss += x[i] * x[i];
        ss += __shfl_xor(ss, 1); ss += __shfl_xor(ss, 2);
        const float rstd = rsqrtf(ss * (1.0f / 64.0f) + RMS_EPS);
        const float* g = (lane < 32 ? a->in[I_DQN] : a->in[I_DKN]) + l * 64 + (lane & 3) * 16;
        const float rq = rstd;
#pragma unroll
        for (int i = 0; i < 16; ++i) x[i] = x[i] * rq * g[i];
        if ((lane & 3) == 0) {
            const float* cp = (const float*)(ws + WS_COSP) + row * 8; const float* sp = (const float*)(ws + WS_SINP) + row * 8;
#pragma unroll
            for (int i = 0; i < 8; ++i) { const float x1 = x[i], x2 = x[i + 8], c = cp[i], s = sp[i]; x[i] = x1 * c - x2 * s; x[i + 8] = x2 * c + x1 * s; }
        }
        *(u32x4*)(P + 16 * lane) = pack8f(x); *(u32x4*)(P + 16 * lane + 8) = pack8f(x + 8);
    }
#pragma unroll
    for (int p = 0; p < 3; ++p) {
        const int rel = 512 * p + 8 * lane;
        float x[8]; unpack8(p == 0 ? ld_f0 : (p == 1 ? ld_f1 : ld_f2), x);
        float ss = 0.f;
#pragma unroll
        for (int i = 0; i < 8; ++i) ss += x[i] * x[i];
        ss += __shfl_xor(ss, 1); ss += __shfl_xor(ss, 2); ss += __shfl_xor(ss, 4); ss += __shfl_xor(ss, 8);
        const float rstd = rsqrtf(ss * (1.0f / 128.0f) + RMS_EPS);
        const float* g = (rel < 768 ? a->in[I_FQN] : a->in[I_FKN]) + l * 128 + (rel & 127);
        const float rq = rstd;
#pragma unroll
        for (int i = 0; i < 8; ++i) x[i] = x[i] * rq * g[i];
        *(u32x4*)(P + C_FQ + rel) = pack8f(x);
    }
    {
        float x[8]; unpack8(ld_q, x);
        float ss = 0.f;
#pragma unroll
        for (int i = 0; i < 8; ++i) ss += x[i] * x[i];
        ss = wave_sum(ss);
        const float rstd = rsqrtf(ss * (1.0f / 512.0f) + RMS_EPS);
#pragma unroll
        for (int i = 0; i < 8; ++i) x[i] *= rstd;
        *(u32x4*)(P + C_MQ + 8 * lane) = pack8f(x);
    }
    {
        const u32x2 w0 = ld_c;
        float x0 = bflo(w0.x), x1 = bfhi(w0.x), x2 = bflo(w0.y), x3 = bfhi(w0.y);
        float ss = wave_sum((x0 * x0 + x1 * x1) + (x2 * x2 + x3 * x3));
        const float rstd = rsqrtf(ss * (1.0f / 256.0f) + RMS_EPS);
        u32x2 o; o.x = cvtpk(x0 * rstd, x1 * rstd); o.y = cvtpk(x2 * rstd, x3 * rstd);
        *(u32x2*)(P + C_CKV + 4 * lane) = o;
    }
    {
        const int j = lane & 7;
        float x[8]; unpack8(ld_k, x);
        float ss = 0.f;
#pragma unroll
        for (int i = 0; i < 8; ++i) ss += x[i] * x[i];
        ss += __shfl_xor(ss, 1); ss += __shfl_xor(ss, 2); ss += __shfl_xor(ss, 4);
        const float rstd = rsqrtf(ss * (1.0f / 64.0f) + RMS_EPS);
        const float* g = a->in[I_MKN] + l * 192 + 8 * j;
        const float* cp = (const float*)(ws + WS_COSM) + row * 32 + 8 * (j & 3); const float* sp = (const float*)(ws + WS_SINM) + row * 32 + 8 * (j & 3);
        float y[8];
#pragma unroll
        for (int i = 0; i < 8; ++i) {
            const float mine = x[i] * rstd * g[i]; const float other = __shfl_xor(mine, 4);
            y[i] = (j < 4) ? (mine * cp[i] - other * sp[i]) : (mine * cp[i] + other * sp[i]);
        }
        if (lane < 8) *(u32x4*)(P + C_KR + 8 * j) = pack8f(y);
    }
    if (lane < 6) {
        const float z = __uint_as_float((unsigned)ld_ff << 16) + a->in[I_FBIAS][l * 6 + lane];
        const float lf = fminf(z, 0.f) - log1pf(expf(-fabsf(z)));
        ((float*)(ws + WS_LOGF))[row * 8 + lane] = lf;
    }
}

__device__ __forceinline__ void fox_cumsum(ArgsP a, int h, LAS unsigned char* lds) {
    int tid_ = threadIdx.x; asm volatile("" : "+v"(tid_));
    const int tid = tid_, lane = tid & 63, wave = tid >> 6;
    const float* lf = (const float*)(a->ws + WS_LOGF); float* cum = (float*)(a->ws + WS_CUM);
    double v[16]; double loc = 0.0;
#pragma unroll
    for (int i = 0; i < 16; ++i) { loc += (double)lf[(16 * tid + i) * 8 + h]; v[i] = loc; }
    double inc = loc;
#pragma unroll
    for (int o = 1; o < 64; o <<= 1) { const double t = __shfl_up(inc, o); if (lane >= o) inc += t; }
    LAS double* wt = (LAS double*)lds;
    if (lane == 63) wt[wave] = inc;
    __syncthreads();
    double pre = inc - loc;
    for (int w = 0; w < wave; ++w) pre += wt[w];
#pragma unroll
    for (int i = 0; i < 16; ++i) cum[(16 * tid + i) * 8 + h] = (float)((pre + v[i]) * 1.4426950408889634);
    __syncthreads();
}

__device__ __forceinline__ void post_mla_row(ArgsP a, int l, int row, int lane) {
    unsigned char* ws = a->ws;
    bf16_t* Q = (bf16_t*)(ws + WS_QC) + (size_t)row * NQUPP;
    bf16_t* KV = (bf16_t*)(ws + WS_KVC) + (size_t)row * NKVUP;
    const int g_r = (lane >> 3) < 6 ? (lane >> 3) : 0;
    const u32x4 ld_r = *(const u32x4*)(Q + g_r * 192 + 8 * (lane & 7));
    const int g_n0 = lane >> 4, g_n1 = (4 + (lane >> 4)) < 6 ? 4 + (lane >> 4) : 0;
    const u32x4 ld_qn0 = *(const u32x4*)(Q + g_n0 * 192 + 64 + 8 * (lane & 15)), ld_qn1 = *(const u32x4*)(Q + g_n1 * 192 + 64 + 8 * (lane & 15));
    const u32x4 ld_kn0 = *(const u32x4*)(KV + g_n0 * 256 + 8 * (lane & 15)), ld_kn1 = *(const u32x4*)(KV + g_n1 * 256 + 8 * (lane & 15));
    {
        const int g = lane >> 3, j = lane & 7; const bool act = g < 6;
        float x[8]; unpack8(ld_r, x);
        float ss = 0.f;
#pragma unroll
        for (int i = 0; i < 8; ++i) ss += x[i] * x[i];
        ss += __shfl_xor(ss, 1); ss += __shfl_xor(ss, 2); ss += __shfl_xor(ss, 4);
        const float rstd = rsqrtf(ss * (1.0f / 64.0f) + RMS_EPS);
        const float* gn = a->in[I_MQN] + l * 192 + 8 * j;
        const float* cp = (const float*)(ws + WS_COSM) + row * 32 + 8 * (j & 3); const float* sp = (const float*)(ws + WS_SINM) + row * 32 + 8 * (j & 3);
        float y[8];
#pragma unroll
        for (int i = 0; i < 8; ++i) {
            const float mine = x[i] * rstd * gn[i]; const float other = __shfl_xor(mine, 4);
            y[i] = (j < 4) ? (mine * cp[i] - other * sp[i]) : (mine * cp[i] + other * sp[i]);
        }
        if (act) *(u32x4*)(Q + g * 192 + 8 * j) = pack8f(y);
    }
#pragma unroll
    for (int p = 0; p < 2; ++p) {
        const int g = 4 * p + (lane >> 4), j = lane & 15; const bool act = g < 6; const int gg = act ? g : 0;
        {
            bf16_t* ptr = Q + gg * 192 + 64 + 8 * j;
            float x[8]; unpack8(p == 0 ? ld_qn0 : ld_qn1, x);
            float ss = 0.f;
#pragma unroll
            for (int i = 0; i < 8; ++i) ss += x[i] * x[i];
            ss += __shfl_xor(ss, 1); ss += __shfl_xor(ss, 2); ss += __shfl_xor(ss, 4); ss += __shfl_xor(ss, 8);
            const float rstd = rsqrtf(ss * (1.0f / 128.0f) + RMS_EPS);
            const float* gn = a->in[I_MQN] + l * 192 + 64 + 8 * j;
#pragma unroll
            for (int i = 0; i < 8; ++i) x[i] = x[i] * rstd * gn[i];
            if (act) *(u32x4*)ptr = pack8f(x);
        }
        {
            bf16_t* ptr = KV + gg * 256 + 8 * j;
            float x[8]; unpack8(p == 0 ? ld_kn0 : ld_kn1, x);
            float ss = 0.f;
#pragma unroll
            for (int i = 0; i < 8; ++i) ss += x[i] * x[i];
            ss += __shfl_xor(ss, 1); ss += __shfl_xor(ss, 2); ss += __shfl_xor(ss, 4); ss += __shfl_xor(ss, 8);
            const float rstd = rsqrtf(ss * (1.0f / 128.0f) + RMS_EPS);
            const float* gn = a->in[I_MKN] + l * 192 + 64 + 8 * j;
#pragma unroll
            for (int i = 0; i < 8; ++i) x[i] = x[i] * rstd * gn[i];
            if (act) *(u32x4*)ptr = pack8f(x);
        }
    }
}

#define SBAR() __builtin_amdgcn_sched_barrier(0)
__device__ __forceinline__ int v_st(int k, int c) { const int kk = (k & ~0xC) | ((k & 4) << 1) | ((k & 8) >> 1); return ((kk >> 3) * 4 + (c >> 5)) * 512 + ((kk & 7) * 32 + (c & 31)) * 2; }
__device__ __forceinline__ int v_rd_base(int lane) { return ((lane & 3) << 3) | (((lane >> 2) & 3) << 6) | (((lane >> 4) & 1) << 5) | (((lane >> 5) & 1) << 8); }
__device__ __forceinline__ int crow(int r, int hi) { return (r & 3) + 8 * (r >> 2) + 4 * hi; }

template <int KW> __device__ __forceinline__ int kswz(int row) {
    return KW == 128 ? (((row & 7) | (((row >> 4) & 1) << 3)) << 4) : ((((row >> 1) & 1) | (((row >> 2) & 1) << 1) | (((row >> 4) & 1) << 2)) << 4);
}
struct AttnP {
    const bf16_t* Q; int qpitch;
    const bf16_t* K0; int k0pitch;
    const bf16_t* K1; int k1pitch;
    const bf16_t* V; int vpitch;
    const float* cum;
    bf16_t* O;
    int P0, rows;
};

__device__ __forceinline__ void pv_tile(f32x16* o, unsigned vb, bf16x8 pa0, bf16x8 pa1, bf16x8 pa2, bf16x8 pa3) {
#define TRRD(dst, off) asm volatile("ds_read_b64_tr_b16 %0, %1 offset:%2" : "=&v"(dst) : "v"(vb), "i"(off) : "memory")
#define VSET(S, d0) do { constexpr int b_ = (d0) * 512; TRRD(S##l0, b_); TRRD(S##h0, b_ + 2048); TRRD(S##l1, b_ + 4096); TRRD(S##h1, b_ + 6144); \
        TRRD(S##l2, b_ + 8192); TRRD(S##h2, b_ + 10240); TRRD(S##l3, b_ + 12288); TRRD(S##h3, b_ + 14336); } while (0)
#define VMMA(S, d0) do { \
        o[d0] = __builtin_amdgcn_mfma_f32_32x32x16_bf16(pa0, (bf16x8){S##l0[0], S##l0[1], S##l0[2], S##l0[3], S##h0[0], S##h0[1], S##h0[2], S##h0[3]}, o[d0], 0, 0, 0); \
        o[d0] = __builtin_amdgcn_mfma_f32_32x32x16_bf16(pa1, (bf16x8){S##l1[0], S##l1[1], S##l1[2], S##l1[3], S##h1[0], S##h1[1], S##h1[2], S##h1[3]}, o[d0], 0, 0, 0); \
        o[d0] = __builtin_amdgcn_mfma_f32_32x32x16_bf16(pa2, (bf16x8){S##l2[0], S##l2[1], S##l2[2], S##l2[3], S##h2[0], S##h2[1], S##h2[2], S##h2[3]}, o[d0], 0, 0, 0); \
        o[d0] = __builtin_amdgcn_mfma_f32_32x32x16_bf16(pa3, (bf16x8){S##l3[0], S##l3[1], S##l3[2], S##l3[3], S##h3[0], S##h3[1], S##h3[2], S##h3[3]}, o[d0], 0, 0, 0); } while (0)
#define LWAIT(n) do { asm volatile("s_waitcnt lgkmcnt(" #n ")" ::: "memory"); SBAR(); } while (0)
    s16x4 Al0, Al1, Al2, Al3, Ah0, Ah1, Ah2, Ah3, Bl0, Bl1, Bl2, Bl3, Bh0, Bh1, Bh2, Bh3;
    VSET(A, 0);
    VSET(B, 1); LWAIT(8); VMMA(A, 0); SBAR();
    VSET(A, 2); LWAIT(8); VMMA(B, 1); SBAR();
    VSET(B, 3); LWAIT(8); VMMA(A, 2); SBAR();
    LWAIT(0); VMMA(B, 3);
#undef LWAIT
#undef VMMA
#undef VSET
#undef TRRD
}

#ifndef ATT_SPLIT
#define ATT_SPLIT 0
#endif
constexpr int UNIT_ROWS = ATT_SPLIT ? 128 : 256, QB_PER_HEAD = SEQ / UNIT_ROWS, NU_B = 256 + 6 * QB_PER_HEAD;
static_assert(NUNITS == 256 + 12 * QB_PER_HEAD, "unit table");
__device__ __forceinline__ void pv_tile_half(f32x16* o, unsigned vb, bf16x8 pa0, bf16x8 pa1) {
#define TRRD(dst, off) asm volatile("ds_read_b64_tr_b16 %0, %1 offset:%2" : "=&v"(dst) : "v"(vb), "i"(off) : "memory")
#define PV_D0H(d0) do { s16x4 l0, l1, h0, h1; constexpr int b_ = (d0) * 512; \
        TRRD(l0, b_); TRRD(h0, b_ + 2048); TRRD(l1, b_ + 4096); TRRD(h1, b_ + 6144); \
        asm volatile("s_waitcnt lgkmcnt(0)" ::: "memory"); SBAR(); \
        o[d0] = __builtin_amdgcn_mfma_f32_32x32x16_bf16(pa0, (bf16x8){l0[0], l0[1], l0[2], l0[3], h0[0], h0[1], h0[2], h0[3]}, o[d0], 0, 0, 0); \
        o[d0] = __builtin_amdgcn_mfma_f32_32x32x16_bf16(pa1, (bf16x8){l1[0], l1[1], l1[2], l1[3], h1[0], h1[1], h1[2], h1[3]}, o[d0], 0, 0, 0); } while (0)
    PV_D0H(0); PV_D0H(1); PV_D0H(2); PV_D0H(3);
#undef PV_D0H
#undef TRRD
}

#ifndef FORCE_SAFE
#define FORCE_SAFE 0
#endif
template <int MODE, int VARI>
__device__ __forceinline__ void attn_unit(LAS unsigned char* lds, const int tid, const AttnP& a, float c2, float lam, const float* subln, float outscale, float fox_u, const bool fast) {
    constexpr bool SPLIT = (MODE != 0) && (ATT_SPLIT != 0);
    constexpr bool WIDE = (MODE != 0) && !SPLIT;
    constexpr int DK = MODE == 0 ? 64 : (MODE == 1 ? 128 : 192), KW = MODE == 2 ? 192 : 128;
    constexpr int VBYTES = 16384, KBYTES = 64 * KW * 2, OFF_K = 3 * VBYTES, OFF_B = OFF_K + 3 * KBYTES, OFF_W = OFF_B + 8 * 3 * 256;
    constexpr int NDMA = KW / 64 + 2 + (MODE == 1 ? 1 : 0);
    const int wid = __builtin_amdgcn_readfirstlane(tid >> 6), lane = tid & 63, r32 = lane & 31, hi = lane >> 5, grp = wid >> 2;
    const int wrow = (WIDE ? wid : (wid & 3)) * 32, kcoff = MODE == 0 ? grp * 64 : 0, khalf = SPLIT ? grp : 0;
    const int NT = (a.P0 + (WIDE ? 256 : 128)) >> 6;
    const int qpos0 = a.P0 + wrow, pos = qpos0 + r32;
    LAS unsigned char* V_lds = lds; LAS unsigned char* K_lds = lds + OFF_K; LAS float* B_lds = (LAS float*)(lds + OFF_B);
    LAS float* wsc = (LAS float*)(lds + OFF_W) + wid * 64; LAS float* li_l = wsc; LAS float* al_l = wsc + 32;
    bf16x8 qr[DK / 16];
    { const bf16_t* qp = a.Q + (size_t)pos * a.qpitch + kcoff + hi * 8;
#pragma unroll
      for (int d0 = 0; d0 < DK / 16; ++d0) qr[d0] = *(const bf16x8*)(qp + d0 * 16); }
    float cP0 = 0.f, ct2 = 0.f; if (MODE == 1) { cP0 = a.cum[(size_t)a.P0 * 8]; ct2 = a.cum[(size_t)pos * 8] - cP0; }
    float sb = 0.f;
#define A_ISSUE_V(t, bf) do { const int k0_ = (t) * 64; int tt_ = tid; asm volatile("" : "+v"(tt_)); const int ln_ = tt_ & 63; \
        _Pragma("unroll") for (int i_ = 0; i_ < 2; ++i_) { const int ch_ = wid + 8 * i_, b_ = ch_ * 1024 + ln_ * 16, sub_ = b_ >> 9, wi_ = (b_ & 511) >> 1; \
            const int kk_ = (sub_ >> 2) * 8 + (wi_ >> 5), c_ = (sub_ & 3) * 32 + (wi_ & 31), k_ = (kk_ & ~0xC) | ((kk_ & 4) << 1) | ((kk_ & 8) >> 1); \
            __builtin_amdgcn_global_load_lds((const unsigned*)(a.V + (size_t)(k0_ + k_) * a.vpitch + c_), (LAS unsigned*)(V_lds + (bf) * VBYTES + ch_ * 1024), 16, 0, 0); } } while (0)
#define A_ISSUE_K(t, bf) do { const int k0_ = (t) * 64; int tt_ = tid; asm volatile("" : "+v"(tt_)); const int ln_ = tt_ & 63; \
        _Pragma("unroll") for (int i_ = 0; i_ < KW / 64; ++i_) { const int ch_ = wid + 8 * i_, b_ = ch_ * 1024 + ln_ * 16, krow_ = b_ / (KW * 2), cs_ = (b_ % (KW * 2)) >> 4; \
            const int kcc_ = cs_ ^ (kswz<KW>(krow_) >> 4); \
            const bf16_t* p_ = (MODE == 2 && kcc_ >= 8) ? a.K1 + (size_t)(k0_ + krow_) * a.k1pitch + (kcc_ - 8) * 8 : a.K0 + (size_t)(k0_ + krow_) * a.k0pitch + kcc_ * 8; \
            __builtin_amdgcn_global_load_lds((const unsigned*)p_, (LAS unsigned*)(K_lds + (bf) * KBYTES + ch_ * 1024), 16, 0, 0); } } while (0)
    const unsigned krb = (unsigned)(uintptr_t)K_lds + r32 * (KW * 2), kxm = kswz<KW>(r32), kcb = kcoff * 2 + hi * 16;
    const unsigned vb0 = (unsigned)(uintptr_t)V_lds + v_rd_base(lane);

    float m_reg = -1e30f, l_reg = 0.f; f32x16 o[4];
#pragma unroll
    for (int d = 0; d < 4; ++d)
#pragma unroll
        for (int r = 0; r < 16; ++r) o[d][r] = 0.f;

    int t_lo = 0;
    if (MODE == 1) {
        const float thr = 150.f + 2.f * fox_u;
        const int ntq = a.P0 >> 6;
        const int pred = (tid < ntq) && (a.cum[(size_t)(tid * 64 + 63) * 8] - cP0 > thr);
        t_lo = __syncthreads_count(pred);
    }
    if (fast && !FORCE_SAFE) {
      f32x2 ls = {0.f, 0.f};
#define QK_TILE(P0_, P1_, SLOT) do { \
        _Pragma("unroll") for (int r = 0; r < 16; ++r) { P0_[r] = 0.f; P1_[r] = 0.f; } \
        _Pragma("unroll") for (int d0 = 0; d0 < DK / 16; ++d0) { const unsigned ad = krb + ((kcb + 32 * d0) ^ kxm) + (SLOT) * KBYTES + khalf * (32 * KW * 2); \
            P0_ = __builtin_amdgcn_mfma_f32_32x32x16_bf16(*(const LAS bf16x8*)(uintptr_t)ad, qr[d0], P0_, 0, 0, 0); \
            if (!SPLIT) P1_ = __builtin_amdgcn_mfma_f32_32x32x16_bf16(*(const LAS bf16x8*)(uintptr_t)(ad + 32 * KW * 2), qr[d0], P1_, 0, 0, 0); } } while (0)
#define PK4F(P, B_, OUT) do { unsigned a0 = cvtpk(P[B_ + 0], P[B_ + 1]), a1 = cvtpk(P[B_ + 2], P[B_ + 3]); \
        unsigned b0 = cvtpk(P[B_ + 4], P[B_ + 5]), b1 = cvtpk(P[B_ + 6], P[B_ + 7]); \
        auto r0 = __builtin_amdgcn_permlane32_swap(a0, b0, false, false); auto r1 = __builtin_amdgcn_permlane32_swap(a1, b1, false, false); \
        u32x4 w = {r0[0], r1[0], r0[1], r1[1]}; OUT = *reinterpret_cast<bf16x8*>(&w); } while (0)
#define SM_GROUP_ON(P_, J_, KO_, MASKED) do { \
        if (MODE == 1) { const f32x4 cb = *(const LAS f32x4*)(Bw_lds + i0 * 64 + (KO_) + 8 * (J_) + 4 * hi); \
            _Pragma("unroll") for (int e = 0; e < 4; ++e) P_[4 * (J_) + e] = fmaf(P_[4 * (J_) + e], c2, ctp - cb[e]); } \
        else { _Pragma("unroll") for (int e = 0; e < 4; ++e) P_[4 * (J_) + e] *= c2; } \
        if (MASKED) { _Pragma("unroll") for (int e = 0; e < 4; ++e) { if (dq - (e + 8 * (J_) + (KO_)) < 0) P_[4 * (J_) + e] = -__builtin_inff(); } } \
        _Pragma("unroll") for (int e = 0; e < 4; ++e) { P_[4 * (J_) + e] = __builtin_amdgcn_exp2f(P_[4 * (J_) + e]); ls[e & 1] += P_[4 * (J_) + e]; } } while (0)
#define SM_SLICE(S_, MASKED) do { \
        if (MODE == 0) { if ((S_) < 2) { SM_GROUP_ON(pA0, 2 * (S_), 0, MASKED); SM_GROUP_ON(pA0, 2 * (S_) + 1, 0, MASKED); } \
                         else { SM_GROUP_ON(pA1, 2 * (S_) - 4, 32, MASKED); SM_GROUP_ON(pA1, 2 * (S_) - 3, 32, MASKED); } \
                         if ((S_) == 0) PK4F(pA0, 0, pa0); else if ((S_) == 1) PK4F(pA0, 8, pa1); else if ((S_) == 2) PK4F(pA1, 0, pa2); else PK4F(pA1, 8, pa3); } \
        else if (WIDE) { if ((S_) < 4) SM_GROUP_ON(pA0, (S_), 0, MASKED); else if ((S_) < 8) SM_GROUP_ON(pA1, (S_) - 4, 32, MASKED); \
                         if ((S_) == 1) PK4F(pA0, 0, pa0); else if ((S_) == 3) PK4F(pA0, 8, pa1); else if ((S_) == 5) PK4F(pA1, 0, pa2); else if ((S_) == 7) PK4F(pA1, 8, pa3); } \
        else if (MODE == 1) { if ((S_) < 4) SM_GROUP_ON(pA0, (S_), 32 * khalf, MASKED); else if ((S_) == 5) PK4F(pA0, 0, pa0); else if ((S_) == 6) PK4F(pA0, 8, pa1); } \
        else { if ((S_) < 8 && !((S_) & 1)) SM_GROUP_ON(pA0, (S_) >> 1, 32 * khalf, MASKED); else if ((S_) == 8) PK4F(pA0, 0, pa0); else if ((S_) == 9) PK4F(pA0, 8, pa1); } } while (0)
#define FAST_TILE(MASKED) do { f32x16 pB0, pB1; bf16x8 pa0, pa1, pa2, pa3; \
        _Pragma("unroll") for (int r = 0; r < 16; ++r) { pB0[r] = 0.f; pB1[r] = 0.f; } \
        _Pragma("unroll") for (int s = 0; s < DK / 16; ++s) { bf16x8 kfa, kfb; SBAR(); \
            { const unsigned ad = krb + ((kcb + 32 * s) ^ kxm) + i1 * KBYTES + khalf * (32 * KW * 2);     \
              kfa = *(const LAS bf16x8*)(uintptr_t)ad; if (!SPLIT) kfb = *(const LAS bf16x8*)(uintptr_t)(ad + 32 * KW * 2); } \
            SM_SLICE(s, MASKED); \
            pB0 = __builtin_amdgcn_mfma_f32_32x32x16_bf16(kfa, qr[s], pB0, 0, 0, 0);     \
            if (!SPLIT) pB1 = __builtin_amdgcn_mfma_f32_32x32x16_bf16(kfb, qr[s], pB1, 0, 0, 0); } \
        SBAR(); \
        if (SPLIT) pv_tile_half(o, vb0 + i0 * VBYTES + khalf * 8192, pa0, pa1); else pv_tile(o, vb0 + i0 * VBYTES, pa0, pa1, pa2, pa3); \
        pA0 = pB0; if (!SPLIT) pA1 = pB1; } while (0)
      unsigned voff[2], koff[KW / 64], kstp[KW / 64], boff = 0; int vt = t_lo, kt = t_lo;
      { int tt_ = tid; asm volatile("" : "+v"(tt_)); const int ln_ = tt_ & 63;
#pragma unroll
        for (int i_ = 0; i_ < 2; ++i_) { const int ch_ = wid + 8 * i_, b_ = ch_ * 1024 + ln_ * 16, sub_ = b_ >> 9, wi_ = (b_ & 511) >> 1;
            const int kk_ = (sub_ >> 2) * 8 + (wi_ >> 5), c_ = (sub_ & 3) * 32 + (wi_ & 31), k_ = (kk_ & ~0xC) | ((kk_ & 4) << 1) | ((kk_ & 8) >> 1);
            voff[i_] = (unsigned)(((t_lo * 64 + k_) * a.vpitch + c_) * 2); }
#pragma unroll
        for (int i_ = 0; i_ < KW / 64; ++i_) { const int ch_ = wid + 8 * i_, b_ = ch_ * 1024 + ln_ * 16, krow_ = b_ / (KW * 2), cs_ = (b_ % (KW * 2)) >> 4;
            const int kcc_ = cs_ ^ (kswz<KW>(krow_) >> 4);
            if (MODE == 2 && kcc_ >= 8) { koff[i_] = (unsigned)((const char*)a.K1 - (const char*)a.K0) + (unsigned)(((t_lo * 64 + krow_) * a.k1pitch + (kcc_ - 8) * 8) * 2); kstp[i_] = (unsigned)(64 * a.k1pitch * 2); }
            else { koff[i_] = (unsigned)(((t_lo * 64 + krow_) * a.k0pitch + kcc_ * 8) * 2); kstp[i_] = (unsigned)(64 * a.k0pitch * 2); } }
        if (MODE == 1) boff = (unsigned)((t_lo * 64 + ln_) * 32); }
#define DMA_V(T_, SLOT) do { \
        _Pragma("unroll") for (int i_ = 0; i_ < 2; ++i_) \
            __builtin_amdgcn_global_load_lds((const unsigned*)((const char*)a.V + voff[i_]), (LAS unsigned*)(V_lds + (SLOT) * VBYTES + (wid + 8 * i_) * 1024), 16, 0, 0); \
        if (MODE == 1) __builtin_amdgcn_global_load_lds((const unsigned*)((const char*)a.cum + boff), (LAS unsigned*)(Bw_lds + (SLOT) * 64), 4, 0, 0); \
        if (vt < NT - 1) { ++vt; _Pragma("unroll") for (int i_ = 0; i_ < 2; ++i_) voff[i_] += (unsigned)(64 * a.vpitch * 2); if (MODE == 1) boff += 64 * 32; } } while (0)
#define DMA_K(T_, SLOT) do { \
        _Pragma("unroll") for (int i_ = 0; i_ < KW / 64; ++i_) \
            __builtin_amdgcn_global_load_lds((const unsigned*)((const char*)a.K0 + koff[i_]), (LAS unsigned*)(K_lds + (SLOT) * KBYTES + (wid + 8 * i_) * 1024), 16, 0, 0); \
        if (kt < NT - 1) { ++kt; _Pragma("unroll") for (int i_ = 0; i_ < KW / 64; ++i_) koff[i_] += kstp[i_]; } } while (0)
      LAS float* Bw_lds = B_lds + wid * 192;
      const float ctp = ct2 + cP0;
      int i0 = t_lo % 3, i1 = (t_lo + 1) % 3, i2 = (t_lo + 2) % 3;
      DMA_K(t_lo, i0); DMA_V(t_lo, i0); DMA_K(t_lo + 1, i1); DMA_V(t_lo + 1, i1); DMA_K(t_lo + 2, i2);
      asm volatile("s_waitcnt vmcnt(0)" ::: "memory"); __builtin_amdgcn_s_barrier(); asm volatile("" ::: "memory");
      f32x16 pA0, pA1;
      QK_TILE(pA0, pA1, i0);
      asm volatile("s_waitcnt lgkmcnt(0)" ::: "memory"); __builtin_amdgcn_s_barrier(); asm volatile("" ::: "memory");
      const int t_nm = a.P0 >> 6;
#define FAST_ITER(MASKED) do { \
        if (!(VARI & 16)) { DMA_K(t + 3, i0);         \
        DMA_V(t + 2, i2); }                           \
        const int dq = pos - t * 64 - 4 * hi; (void)dq; \
        FAST_TILE(MASKED); \
        if (!(VARI & 8)) { asm volatile("s_waitcnt vmcnt(%0)" :: "n"(NDMA) : "memory");     \
        __builtin_amdgcn_s_barrier(); } asm volatile("" ::: "memory"); \
        { const int r_ = i0; i0 = i1; i1 = i2; i2 = r_; } } while (0)
      int t = t_lo;
      for (; t < t_nm; ++t) FAST_ITER(false);
      for (; t < NT; ++t) FAST_ITER(true);
#undef FAST_ITER
#undef DMA_K
#undef DMA_V
#undef FAST_TILE
#undef SM_SLICE
#undef SM_GROUP_ON
#undef PK4F
#undef QK_TILE
      { float ps = ls[0] + ls[1];
        auto rr = __builtin_amdgcn_permlane32_swap(__float_as_uint(ps), __float_as_uint(ps), false, false);
        l_reg = __uint_as_float(rr[0]) + __uint_as_float(rr[1]); }
    } else {
    int tl_ = lane; asm volatile("" : "+v"(tl_));
    const int r32_s = tl_ & 31, hi_s = tl_ >> 5, pos_s = qpos0 + r32_s;
    const unsigned krb_s = (unsigned)(uintptr_t)K_lds + r32_s * (KW * 2), kxm_s = kswz<KW>(r32_s), kcb_s = kcoff * 2 + hi_s * 16;
    const unsigned vb0_s = (unsigned)(uintptr_t)V_lds + v_rd_base(tl_);
    const bool active = !SPLIT || wid < 4;
#define S_ISSUE(t, bf) do { A_ISSUE_V(t, bf); A_ISSUE_K(t, bf); if (MODE == 1) { int tt_ = tid; asm volatile("" : "+v"(tt_)); if (tt_ < 64) sb = cP0 - a.cum[(size_t)((t) * 64 + tt_) * 8]; } } while (0)
#define S_WRITE(bf) do { if (MODE == 1) { int tt_ = tid; asm volatile("" : "+v"(tt_)); if (tt_ < 64) B_lds[(bf) * 64 + tt_] = sb; } } while (0)
    S_ISSUE(t_lo, t_lo & 1); S_WRITE(t_lo & 1);
    __syncthreads();
    for (int t = t_lo; t < NT; ++t) {
        const int bf = t & 1;
        if (t + 1 < NT) S_ISSUE(t + 1, bf ^ 1);
        if (active) {
        f32x16 p0, p1;
#pragma unroll
        for (int r = 0; r < 16; ++r) { p0[r] = 0.f; p1[r] = 0.f; }
#pragma unroll
        for (int d0 = 0; d0 < DK / 16; ++d0) {
            const unsigned ad = krb_s + ((kcb_s + 32 * d0) ^ kxm_s) + bf * KBYTES;
            const bf16x8 b0 = *(const LAS bf16x8*)(uintptr_t)ad;
            const bf16x8 b1 = *(const LAS bf16x8*)(uintptr_t)(ad + 32 * KW * 2);
            p0 = __builtin_amdgcn_mfma_f32_32x32x16_bf16(b0, qr[d0], p0, 0, 0, 0);
            p1 = __builtin_amdgcn_mfma_f32_32x32x16_bf16(b1, qr[d0], p1, 0, 0, 0);
            if ((d0 & 3) == 3) SBAR();
        }
        if (MODE == 1) {
#pragma unroll
            for (int j = 0; j < 4; ++j) {
                const f32x4 c0 = *(const LAS f32x4*)(B_lds + bf * 64 + 8 * j + 4 * hi_s), c1 = *(const LAS f32x4*)(B_lds + bf * 64 + 32 + 8 * j + 4 * hi_s);
#pragma unroll
                for (int e = 0; e < 4; ++e) { p0[4 * j + e] = fmaf(p0[4 * j + e], c2, ct2 + c0[e]); p1[4 * j + e] = fmaf(p1[4 * j + e], c2, ct2 + c1[e]); }
            }
        } else {
#pragma unroll
            for (int r = 0; r < 16; ++r) { p0[r] *= c2; p1[r] *= c2; }
        }
        if (t * 64 + 63 > qpos0) {
            const int dq = pos_s - t * 64 - 4 * hi_s; const float NEG = -__builtin_inff();
#pragma unroll
            for (int r = 0; r < 16; ++r) { const int cc = (r & 3) + 8 * (r >> 2); if (dq - cc < 0) p0[r] = NEG; if (dq - cc - 32 < 0) p1[r] = NEG; }
        }
        float pmax = p0[0];
#pragma unroll
        for (int r = 1; r < 16; ++r) pmax = fmaxf(pmax, p0[r]);
#pragma unroll
        for (int r = 0; r < 16; ++r) pmax = fmaxf(pmax, p1[r]);
        { auto rr = __builtin_amdgcn_permlane32_swap(__float_as_uint(pmax), __float_as_uint(pmax), false, false);
          pmax = fmaxf(__uint_as_float(rr[0]), __uint_as_float(rr[1])); }
        float mn, alpha;
        if (__all(pmax - m_reg <= 8.0f)) { mn = m_reg; alpha = 1.f; }
        else { mn = fmaxf(m_reg, pmax); alpha = __builtin_amdgcn_exp2f(m_reg - mn); m_reg = mn; }
        float ps = 0.f;
#pragma unroll
        for (int r = 0; r < 16; ++r) { p0[r] = __builtin_amdgcn_exp2f(p0[r] - mn); p1[r] = __builtin_amdgcn_exp2f(p1[r] - mn); }
#pragma unroll
        for (int r = 0; r < 16; ++r) ps += p0[r] + p1[r];
        { auto rr = __builtin_amdgcn_permlane32_swap(__float_as_uint(ps), __float_as_uint(ps), false, false);
          ps = __uint_as_float(rr[0]) + __uint_as_float(rr[1]); }
        l_reg = l_reg * alpha + ps;
        bf16x8 pa0, pa1, pa2, pa3;
#define PK4(P, B_, OUT) do { unsigned a0 = cvtpk(P[B_ + 0], P[B_ + 1]), a1 = cvtpk(P[B_ + 2], P[B_ + 3]); \
        unsigned b0 = cvtpk(P[B_ + 4], P[B_ + 5]), b1 = cvtpk(P[B_ + 6], P[B_ + 7]); \
        auto r0 = __builtin_amdgcn_permlane32_swap(a0, b0, false, false); auto r1 = __builtin_amdgcn_permlane32_swap(a1, b1, false, false); \
        u32x4 w = {r0[0], r1[0], r0[1], r1[1]}; OUT = *reinterpret_cast<bf16x8*>(&w); } while (0)
        PK4(p0, 0, pa0); PK4(p0, 8, pa1); PK4(p1, 0, pa2); PK4(p1, 8, pa3);
#undef PK4
        if (__any(alpha < 1.f)) {
            if (hi_s == 0) al_l[r32_s] = alpha;
            asm volatile("s_waitcnt lgkmcnt(0)" ::: "memory");
#pragma unroll
            for (int r = 0; r < 16; ++r) { const float al = al_l[crow(r, hi_s)];
#pragma unroll
                for (int d = 0; d < 4; ++d) o[d][r] *= al; }
        }
        pv_tile(o, vb0_s + bf * VBYTES, pa0, pa1, pa2, pa3);
        }
        if (t + 1 < NT) S_WRITE(bf ^ 1);
        __syncthreads();
    }
#undef S_ISSUE
#undef S_WRITE
    }
#undef A_ISSUE_V
#undef A_ISSUE_K
    asm volatile("s_waitcnt vmcnt(0)" ::: "memory");
    __syncthreads();
    LAS float* X = (LAS float*)lds + (wid & 3) * 4096 + lane;
    LAS float* LX = (LAS float*)(lds + 65536) + (wid & 3) * 32;
    if (MODE == 0) {
        if (hi == 0) li_l[r32] = l_reg;
        asm volatile("s_waitcnt lgkmcnt(0)" ::: "memory");
#pragma unroll
        for (int r = 0; r < 16; ++r) { const float rl = __builtin_amdgcn_rcpf(li_l[crow(r, hi)]);
#pragma unroll
            for (int d = 0; d < 4; ++d) o[d][r] *= rl; }
        if (wid >= 4) {
#pragma unroll
            for (int d = 0; d < 4; ++d)
#pragma unroll
                for (int r = 0; r < 16; ++r) X[(d * 16 + r) * 64] = o[d][r];
        }
        __syncthreads();
        if (wid < 4) {
            const float g0 = subln[r32], g1 = subln[32 + r32], g2 = subln[64 + r32], g3 = subln[96 + r32];
#pragma unroll
            for (int r = 0; r < 16; ++r) {
                float v[4]; float ss = 0.f;
#pragma unroll
                for (int d = 0; d < 4; ++d) { v[d] = o[d][r] - lam * X[(d * 16 + r) * 64]; ss += v[d] * v[d]; }
                ss += __shfl_xor(ss, 1); ss += __shfl_xor(ss, 2); ss += __shfl_xor(ss, 4); ss += __shfl_xor(ss, 8); ss += __shfl_xor(ss, 16);
                const float rs = rsqrtf(ss * (1.0f / 128.0f) + RMS_EPS) * outscale;
                o[0][r] = v[0] * rs * g0; o[1][r] = v[1] * rs * g1; o[2][r] = v[2] * rs * g2; o[3][r] = v[3] * rs * g3;
            }
        }
    } else if (WIDE) {
        if (hi == 0) li_l[r32] = l_reg;
        asm volatile("s_waitcnt lgkmcnt(0)" ::: "memory");
#pragma unroll
        for (int r = 0; r < 16; ++r) { const float rl = __builtin_amdgcn_rcpf(li_l[crow(r, hi)]);
#pragma unroll
            for (int d = 0; d < 4; ++d) o[d][r] *= rl; }
    } else {
        if (wid >= 4) {
#pragma unroll
            for (int d = 0; d < 4; ++d)
#pragma unroll
                for (int r = 0; r < 16; ++r) X[(d * 16 + r) * 64] = o[d][r];
            if (hi == 0) LX[r32] = l_reg;
        }
        __syncthreads();
        if (wid < 4) {
            if (hi == 0) li_l[r32] = l_reg + LX[r32];
            asm volatile("s_waitcnt lgkmcnt(0)" ::: "memory");
#pragma unroll
            for (int r = 0; r < 16; ++r) { const float rl = __builtin_amdgcn_rcpf(li_l[crow(r, hi)]);
#pragma unroll
                for (int d = 0; d < 4; ++d) o[d][r] = (o[d][r] + X[(d * 16 + r) * 64]) * rl; }
        }
    }
    if (WIDE || wid < 4) {
        bf16_t* Ow = a.O + (size_t)qpos0 * 2048;
#pragma unroll
        for (int r = 0; r < 16; ++r) { const int orow = crow(r, hi);
#pragma unroll
            for (int d = 0; d < 4; ++d) { const float v = o[d][r]; const float vn = __shfl_xor(v, 1);
                if ((r32 & 1) == 0) *(unsigned*)(Ow + (size_t)orow * 2048 + d * 32 + r32) = cvtpk(v, vn); } }
    }
    __syncthreads();
}

#ifndef DUP
#define DUP 0
#endif
#ifndef AV
#define AV 0
#endif
__device__ __forceinline__ void tr_drain(ArgsP a, LAS unsigned char* lds, int tid, int* counter, int l, int late, int max_chunks) {
    LAS int* slot = (LAS int*)(lds + LDS_BYTES - 64);
    const int lane = tid & 63, wave = __builtin_amdgcn_readfirstlane(tid >> 6), n_items = late ? TR_N_LATE : TR_N_EARLY, n_chunks = (n_items + TR_CHUNK - 1) / TR_CHUNK;
    LAS float* scr = (LAS float*)(lds + wave * 8704);
    for (int n = 0; n < max_chunks; ++n) {
        if (tid == 0) *slot = atomicAdd(counter, 1);
        __syncthreads();
        const int ch = *slot;
        __syncthreads();
        if (ch >= n_chunks) break;
#pragma unroll 1
        for (int j = 0; j < TR_CHUNK / 8; ++j) { const int i = ch * TR_CHUNK + wave * (TR_CHUNK / 8) + j; if (i < n_items) tr_dispatch(a, l, late ? tr_late_item(i) : tr_early_item(i), scr, lane); }
    }
}
template <int VARI>
__device__ __forceinline__ void attention_phase(ArgsP a, int l, LAS unsigned char* lds, int cslot) {
    unsigned char* ws = a->ws;
    const bf16_t* PROJ = (const bf16_t*)(ws + WS_PROJ); const bf16_t* QC = (const bf16_t*)(ws + WS_QC); const bf16_t* KVC = (const bf16_t*)(ws + WS_KVC);
    bf16_t* MIX = (bf16_t*)(ws + (VARI == 0 ? WS_MIX : WS_END));
    const int* table = (const int*)(ws + WS_TABLE); int* counter = (int*)(ws + WS_CNT) + 4 * (l + cslot);
    LAS int* slot = (LAS int*)(lds + LDS_BYTES - 64);
    const float lam = ((const float*)(ws + WS_LAM))[l], fox_u = ((const float*)(ws + WS_LAM))[8 + l], ub_a = ((const float*)(ws + WS_LAM))[12 + l], ub_c = ((const float*)(ws + WS_LAM))[16 + l];
    const float linit = 0.8f - 0.6f * expf(-0.3f * (float)l);
    int tid_ = threadIdx.x; asm volatile("" : "+v"(tid_)); const int tid = tid_;
    for (;;) {
        if (tid == 0) *slot = atomicAdd(counter, 1);
        __syncthreads();
        const int idx = *slot;
        __syncthreads();
        if (idx >= NUNITS) break;
        const int id = table[idx];
        int tu_ = tid; asm volatile("" : "+v"(tu_)); const int tu = tu_;
        AttnP p{};
#ifndef ATM
#define ATM 7
#endif
        if (id < 256 && (ATM & 1) && (VARI == 0 || (VARI & 1))) {
            const int h = id >> 6, qb = id & 63;
            p.Q = PROJ + C_DQ + h * 128; p.qpitch = NINP; p.K0 = PROJ + C_DK + h * 128; p.k0pitch = NINP; p.K1 = p.K0; p.k1pitch = NINP;
            p.V = PROJ + C_DV + h * 128; p.vpitch = NINP; p.cum = nullptr; p.O = MIX + h * 128; p.P0 = qb * 128; p.rows = 128;
            attn_unit<0, VARI>(lds, tu, p, 0.125f * LOG2E, lam, a->in[I_SUBLN] + l * 128, 1.0f - linit, 0.f, ub_a < 60.f);
        } else if (id >= 256 && id < NU_B && (ATM & 2) && (VARI == 0 || (VARI & 2))) {
            const int h = (id - 256) / QB_PER_HEAD, qb = (id - 256) % QB_PER_HEAD;
            p.Q = PROJ + C_FQ + h * 128; p.qpitch = NINP; p.K0 = PROJ + C_FK + h * 128; p.k0pitch = NINP; p.K1 = p.K0; p.k1pitch = NINP;
            p.V = PROJ + C_FV + h * 128; p.vpitch = NINP; p.cum = (const float*)(ws + WS_CUM) + h; p.O = MIX + 512 + h * 128; p.P0 = qb * UNIT_ROWS; p.rows = UNIT_ROWS;
            attn_unit<1, VARI>(lds, tu, p, 0.08838834764831845f * LOG2E, 0.f, nullptr, 1.f, fox_u, fox_u < 60.f);
        } else if (id >= NU_B && (ATM & 4) && (VARI == 0 || (VARI & 4))) {
            const int h = (id - NU_B) / QB_PER_HEAD, qb = (id - NU_B) % QB_PER_HEAD;
            p.Q = QC + h * 192; p.qpitch = NQUPP; p.K0 = PROJ + C_KR; p.k0pitch = NINP; p.K1 = KVC + h * 256; p.k1pitch = NKVUP;
            p.V = KVC + h * 256 + 128; p.vpitch = NKVUP; p.cum = nullptr; p.O = MIX + 1280 + h * 128; p.P0 = qb * UNIT_ROWS; p.rows = UNIT_ROWS;
            attn_unit<2, VARI>(lds, tu, p, 0.07216878364870322f * LOG2E, 0.f, nullptr, 1.f, 0.f, ub_c < 60.f);
        }
    }    if (VARI == 0) {
        int* cnt = (int*)(ws + WS_CNT);
        tr_drain(a, lds, tid, cnt + 24 + 2 * l, l, 1, 1 << 20);
        if (l == 0) tr_drain(a, lds, tid, cnt + 25, 1, 0, 1 << 20);
    }
}

#ifndef PHM
#define PHM 0x1ff
#endif
constexpr int PH_PER_LAYER = 8, N_PHASES = 1 + 2 * PH_PER_LAYER;
__global__ void __launch_bounds__(512, 2) fwd_kernel(Args a_unused) {
    extern __shared__ __attribute__((aligned(16))) unsigned char lds_raw[];
    LAS unsigned char* lds = (LAS unsigned char*)lds_raw;
    cg::grid_group grid = cg::this_grid();
    ArgsP a0 = (ArgsP)__builtin_amdgcn_kernarg_segment_ptr();
    const int G = gridDim.x, ph_lo = a0->ph_lo, ph_hi = a0->ph_hi;
    volatile LAS unsigned* bst = (volatile LAS unsigned*)(lds + 131072 + 128);
    if (threadIdx.x == 0) { bst[0] = 0u; bst[1] = 0u; }
    __syncthreads();
    (void)xcd_barrier_post((unsigned*)(a0->ws + WS_BAR), bst);
    int ph = ph_lo;
    if (ph_hi > 1000) grid.sync();
    if (ph == 0) {
        ArgsP ap = a0; asm volatile("" : "+s"(ap)); if (PHM & 1) prologue(ap, lds);
        ph = 1;
        if (ph < ph_hi) { XcdBarrier b2; b2.bar = (unsigned*)(ap->ws + WS_BAR); b2.x = xb_xcc_id(); b2.st = bst; xcd_barrier(b2); }
    }
    for (; ph < ph_hi; ++ph) {
        ArgsP a = a0; asm volatile("" : "+s"(a));
        unsigned char* ws = a->ws;
        bf16_t* XB = (bf16_t*)(ws + WS_XB); float* XF = (float*)(ws + WS_XF); bf16_t* MIX = (bf16_t*)(ws + WS_MIX); bf16_t* PROJ = (bf16_t*)(ws + WS_PROJ);
        bf16_t* QC = (bf16_t*)(ws + WS_QC); bf16_t* KVC = (bf16_t*)(ws + WS_KVC); bf16_t* HB = (bf16_t*)(ws + WS_H); float* SSQ = (float*)(ws + WS_SSQ);
                const int l = (ph - 1) / PH_PER_LAYER, sp = (ph - 1) % PH_PER_LAYER;
        int tid_ = threadIdx.x; asm volatile("" : "+v"(tid_));
        const int lane = tid_ & 63, wave = __builtin_amdgcn_readfirstlane(tid_ >> 6), gw = blockIdx.x * 8 + wave, NGW = G * 8;
        if (sp == 0 && (PHM & 2)) {
            pg8::Gemm g{XB, (const bf16_t*)(ws + WS_WIN + l * SZ_WIN), SEQ, NINP, DM, DM}; pg8::StaticOrder S; S.init(SEQ, NINP, G, (int)blockIdx.x);
            pg8::EpiScaleBf16<false> E{PROJ, NINP, SSQ + (2 * l) * SEQ};
            pg8::gemm_phase<pg8::EpiScaleBf16<false>, pg8::StaticOrder, true, true>(lds, g, S, E);
            if ((int)blockIdx.x >= (SEQ / 256) * (NINP / 256) - 2 * G) tr_drain(a, lds, tid_, (int*)(ws + WS_CNT) + 24 + 2 * l, l, 1, 3);
        } else if (sp == 1 && (PHM & 4)) {
            for (int m = gw; m < SEQ; m += NGW) post_proj_row(a, l, m, lane);
        } else if (sp == 2 && (PHM & 8)) {
            if (blockIdx.x < 6) fox_cumsum(a, blockIdx.x, lds);
            { pg8::Gemm g{PROJ + C_MQ, (const bf16_t*)(ws + WS_WQUP + l * SZ_WQUP), SEQ, NQUPP, 512, NINP}; pg8::StaticOrder S; S.init(SEQ, NQUPP, G, (int)blockIdx.x);
              pg8::EpiScaleBf16<false> E{QC, NQUPP, nullptr};
              pg8::gemm_phase<pg8::EpiScaleBf16<false>, pg8::StaticOrder, true, true>(lds, g, S, E); }
            { pg8::Gemm g{PROJ + C_CKV, (const bf16_t*)(ws + WS_WKVUP + l * SZ_WKVUP), SEQ, NKVUP, 256, NINP}; pg8::StaticOrder S; S.init(SEQ, NKVUP, G, (int)((blockIdx.x + 128) % G));
              pg8::EpiScaleBf16<false> E{KVC, NKVUP, nullptr};
              pg8::gemm_phase<pg8::EpiScaleBf16<false>, pg8::StaticOrder, true, true>(lds, g, S, E); }
        } else if (sp == 3 && (PHM & 16)) {
            for (int m = gw; m < SEQ; m += NGW) post_mla_row(a, l, m, lane);
        } else if (sp == 4 && (PHM & 32)) {
            attention_phase<0>(a, l, lds, 0);
#if DUP & 1
            { XcdBarrier b2; b2.bar = (unsigned*)(a->ws + WS_BAR); b2.x = xb_xcc_id(); b2.st = bst; xcd_barrier(b2); } attention_phase<AV>(a, l, lds, 2);
#endif
        } else if (sp == 5 && (PHM & 64)) {
            pg8::Gemm g{MIX, (const bf16_t*)(ws + WS_WOUT + l * SZ_WOUT), SEQ, DM, DM, DM}; pg8::StaticOrder S; S.init(SEQ, DM, G, (int)blockIdx.x);
            pg8::EpiResid E{l == 0 ? a->in[I_X] : (const float*)XF, XF, XB, SSQ + (2 * l + 1) * SEQ};
            pg8::gemm_phase<pg8::EpiResid, pg8::StaticOrder, true, true>(lds, g, S, E);
        } else if (sp == 6 && (PHM & 128)) {
            pg8::Gemm g{XB, (const bf16_t*)(ws + WS_WUP + l * SZ_WUP), SEQ, DFF, DM, DM}; pg8::StaticOrder S; S.init(SEQ, DFF, G, (int)blockIdx.x);
            pg8::EpiScaleBf16<true> E{HB, DFF, SSQ + (2 * l + 1) * SEQ};
            pg8::gemm_phase<pg8::EpiScaleBf16<true>, pg8::StaticOrder, true, true>(lds, g, S, E);
#if DUP & 4
            { XcdBarrier b2; b2.bar = (unsigned*)(a->ws + WS_BAR); b2.x = xb_xcc_id(); b2.st = bst; xcd_barrier(b2); } pg8::gemm_phase<pg8::EpiScaleBf16<true>, pg8::StaticOrder, true, true>(lds, g, S, E);
#endif
        } else if (sp == 7 && (PHM & 256)) {
            pg8::Gemm g{HB, (const bf16_t*)(ws + WS_WDN + l * SZ_WDN), SEQ, DM, DFF, DFF}; pg8::StaticOrder S; S.init(SEQ, DM, G, (int)blockIdx.x);
            pg8::EpiResid E{XF, l == 1 ? a->out : XF, l == 1 ? nullptr : XB, l == 1 ? nullptr : SSQ + 2 * SEQ};
            pg8::gemm_phase<pg8::EpiResid, pg8::StaticOrder, true, true>(lds, g, S, E);
        }
        if (ph + 1 < ph_hi) { XcdBarrier b2; b2.bar = (unsigned*)(a->ws + WS_BAR); b2.x = xb_xcc_id(); b2.st = bst; xcd_barrier(b2); }
    }
}

#ifndef ONE_LAUNCH
#define ONE_LAUNCH 1
#endif
extern "C" void kernel_launch(void* const* d_in, const int* in_sizes, int n_in, void* d_out, int out_size, void* d_ws, size_t ws_size, hipStream_t stream) {
    static int grid = 0;
    if (grid == 0) {
        if (n_in != 23 || out_size != SEQ * DM || ws_size < WS_END + 32 * MiB) { fprintf(stderr, "kernel_launch: unexpected shapes (n_in %d out %d ws %zu)\n", n_in, out_size, ws_size); grid = -1; return; }
        int dev = 0, cus = 0, per_cu = 0;
        (void)hipGetDevice(&dev); (void)hipDeviceGetAttribute(&cus, hipDeviceAttributeMultiprocessorCount, dev);
        if (hipFuncSetAttribute((const void*)fwd_kernel, hipFuncAttributeMaxDynamicSharedMemorySize, LDS_BYTES) != hipSuccess) { fprintf(stderr, "kernel_launch: hipFuncSetAttribute failed\n"); grid = -1; return; }
        if (hipOccupancyMaxActiveBlocksPerMultiprocessor(&per_cu, (const void*)fwd_kernel, 512, LDS_BYTES) != hipSuccess || per_cu < 1) { fprintf(stderr, "kernel_launch: occupancy query says %d\n", per_cu); per_cu = 1; }
        (void)hipGetLastError();
        if (cus <= 0) cus = 256;
        grid = cus;
    }
    if (grid < 0) return;
    if (hipMemsetAsync((char*)d_ws + WS_BAR, 0, XCD_BAR_WORDS * 4, stream) != hipSuccess) { fprintf(stderr, "kernel_launch: hipMemsetAsync failed\n"); return; }
    Args a{};
    for (int i = 0; i < 23; ++i) a.in[i] = (const float*)d_in[i];
    a.out = (float*)d_out; a.ws = (unsigned char*)d_ws;
#if ONE_LAUNCH
    a.ph_lo = 0; a.ph_hi = N_PHASES;
    { void* args[] = {&a};
      hipError_t e = hipLaunchCooperativeKernel((const void*)fwd_kernel, dim3(grid), dim3(512), args, LDS_BYTES, stream);
      if (e != hipSuccess) fprintf(stderr, "cooperative launch failed: %s (grid %d)\n", hipGetErrorString(e), grid); }
#else
    for (int ph = 0; ph < N_PHASES; ++ph) {
        a.ph_lo = ph; a.ph_hi = ph + 1;
        void* args[] = {&a};
        hipError_t e = hipLaunchCooperativeKernel((const void*)fwd_kernel, dim3(grid), dim3(512), args, LDS_BYTES, stream);
        if (e != hipSuccess) { fprintf(stderr, "cooperative launch %d failed: %s (grid %d)\n", ph, hipGetErrorString(e), grid); break; }
    }
#endif
}
```

```cpp
#include <hip/hip_runtime.h>
#include <hip/hip_cooperative_groups.h>
#include <cstdio>
#include <cstdint>
namespace cg = cooperative_groups;
constexpr float RMS_EPS = 1e-6f;
namespace pg8 {
#define PG8_LAS __attribute__((address_space(3)))
typedef unsigned short bf16_t;
typedef short bf16x8 __attribute__((ext_vector_type(8)));
typedef float f32x4 __attribute__((ext_vector_type(4)));
typedef unsigned u32x4 __attribute__((ext_vector_type(4)));
constexpr int BM = 256, BK = 64, HALF = 128, HTB = HALF * BK * 2  , STAGE_BYTES = 8 * HTB, NXCD = 8, WGM = 2;

__host__ __device__ __forceinline__ int lds_byte(int r, int c) { const int st = (r >> 4) * 2 + (c >> 5), rr = r & 15, cc = c & 31, ob = rr * 64 + cc * 2; return st * 1024 + (ob ^ (((ob >> 9) & 1) << 5)); }
__host__ __device__ __forceinline__ void stage_rc(int b, int& R, int& C) { const int st = b / 1024, sb = b % 1024, swz = sb ^ (((sb >> 9) & 1) << 5); R = (st >> 1) * 16 + swz / 64; C = (st & 1) * 32 + (swz % 64) / 2; }
__host__ __device__ __forceinline__ int perm32(int rho) { const int n = rho >> 4, i = rho & 15; return 8 * (i >> 2) + 4 * n + (i & 3); }

struct Unit { int pm, pn; };
struct Gemm { const bf16_t* A; const bf16_t* Bt; int M, N, K, lda; };

struct StaticOrder {
    int nM, nN, nwg, G, c;
    __host__ __device__ void init(int M, int N, int G_, int c_) { nM = M / BM; nN = N / BM; nwg = nM * nN; G = G_; c = c_; }
    __host__ __device__ bool next(int i, Unit& u) const {
        const long L = (long)i * G + c; if (L >= nwg) return false;
        int wgid = (int)L; { const int q = nwg / NXCD, r = nwg % NXCD, xcd = wgid % NXCD, off = wgid / NXCD; wgid = (xcd < r ? xcd * (q + 1) : r * (q + 1) + (xcd - r) * q) + off; }
        const int nig = WGM * nN, gid = wgid / nig, fm = gid * WGM, gsz = (nM - fm) < WGM ? (nM - fm) : WGM;
        u.pm = fm + ((wgid % nig) % gsz); u.pn = (wgid % nig) / gsz; return true;
    }
    __device__ __forceinline__ void a_ready(const Unit&) const {}
    __device__ __forceinline__ void done(const Unit&) const {}
};

typedef float cvt2_f32x2 __attribute__((ext_vector_type(2))); typedef __bf16 cvt2_bf16x2 __attribute__((ext_vector_type(2)));
__device__ __forceinline__ unsigned cvt_pk_bf16(float lo, float hi) { const cvt2_f32x2 v = {lo, hi}; const cvt2_bf16x2 r = __builtin_convertvector(v, cvt2_bf16x2); return __builtin_bit_cast(unsigned, r); }


template <bool RELU2> struct EpiScaleBf16 {
    static constexpr bool PERM = true, AFTER_DRAIN = false;
    bf16_t* O; int ldc; const float* ssq;
    __device__ __forceinline__ void operator()(const f32x4 (&acc)[2][2][4][2], const Unit& u, int wr, int wc, int fr, int fq) const {
        const int row0 = u.pm * BM + wr * 64 + fr, col0 = u.pn * BM + wc * 32 + 8 * fq;
#pragma unroll
        for (int ai = 0; ai < 2; ++ai)
#pragma unroll
            for (int m = 0; m < 4; ++m) {
                const int row = row0 + ai * HALF + m * 16;
                const float rs = ssq ? rsqrtf(ssq[row] * (1.0f / 2048.0f) + RMS_EPS) : 1.0f;
                bf16_t* rowp = O + (size_t)row * ldc + col0;
#pragma unroll
                for (int bj = 0; bj < 2; ++bj) {
                    f32x4 v0 = acc[ai][bj][m][0] * rs, v1 = acc[ai][bj][m][1] * rs;
                    if (RELU2) {
#pragma unroll
                        for (int e = 0; e < 4; ++e) { float a = fmaxf(v0[e], 0.f), b = fmaxf(v1[e], 0.f); v0[e] = a * a; v1[e] = b * b; }
                    }
                    u32x4 w; w.x = cvt_pk_bf16(v0[0], v0[1]); w.y = cvt_pk_bf16(v0[2], v0[3]); w.z = cvt_pk_bf16(v1[0], v1[1]); w.w = cvt_pk_bf16(v1[2], v1[3]);
                    *(u32x4*)(rowp + bj * HALF) = w;
                }
            }
    }
};
struct EpiResid {
    static constexpr bool PERM = false, AFTER_DRAIN = false;
    const float* base; float* out; bf16_t* xb; float* ssq;
    __device__ __forceinline__ void operator()(const f32x4 (&acc)[2][2][4][2], const Unit& u, int wr, int wc, int fr, int fq) const {
        typedef unsigned u32x2 __attribute__((ext_vector_type(2)));
        const int row0 = u.pm * BM + wr * 64 + fr, col0 = u.pn * BM + wc * 32 + 4 * fq;
#pragma unroll
        for (int ai = 0; ai < 2; ++ai)
#pragma unroll
            for (int m = 0; m < 4; ++m) {
                const int row = row0 + ai * HALF + m * 16;
                const size_t off = (size_t)row * 2048 + col0;
                float s = 0.f;
#pragma unroll
                for (int bj = 0; bj < 2; ++bj)
#pragma unroll
                    for (int n = 0; n < 2; ++n) {
                        const f32x4 b = *(const f32x4*)(base + off + bj * HALF + n * 16);
                        const f32x4 v = b + acc[ai][bj][m][n];
                        *(f32x4*)(out + off + bj * HALF + n * 16) = v;
                        if (xb) { u32x2 w; w.x = cvt_pk_bf16(v[0], v[1]); w.y = cvt_pk_bf16(v[2], v[3]); *(u32x2*)(xb + off + bj * HALF + n * 16) = w; }
                        s += (v[0] * v[0] + v[1] * v[1]) + (v[2] * v[2] + v[3] * v[3]);
                    }
                if (ssq) { s += __shfl_xor(s, 16); s += __shfl_xor(s, 32); if (fq == 0) unsafeAtomicAdd(ssq + row, s); }
            }
    }
};
template <class Epi, class Sched, bool ALIGN_EPI = false, bool SP2 = false>
__device__ __forceinline__ void gemm_phase(PG8_LAS unsigned char* lds, const Gemm g, const Sched& S, const Epi& E) {
    int tid_ = threadIdx.x; asm volatile("" : "+v"(tid_));
    const int tid = tid_, wid = __builtin_amdgcn_readfirstlane(tid >> 6), lane = tid & 63, wr = wid >> 2, wc = wid & 3, fr = lane & 15, fq = lane >> 4;
    const int K = g.K, nt = K / BK;
    unsigned voffA[2], voffB[2];
#pragma unroll
    for (int i = 0; i < 2; ++i) { int R, C; stage_rc(tid * 16 + i * 8192, R, C); const int Rb = Epi::PERM ? ((R & ~31) + perm32(R & 31)) : R;
        voffA[i] = (unsigned)(R * g.lda + C) * 2u; voffB[i] = (unsigned)(Rb * K + C) * 2u; }
    const size_t kstep = (size_t)(BK * 2);
    const size_t hstepA = (size_t)HALF * g.lda * 2, hstepB = (size_t)HALF * K * 2;
    const size_t tstepA = 2 * hstepA, tstepB = 2 * hstepB;
    const unsigned ldsw = (unsigned)wid * 1024u;
    const int aoff = lds_byte(wr * 64 + fr, fq * 8), boff = lds_byte(wc * 32 + fr, fq * 8);
#define PG8_SA(b, h) (((b) * 2 + (h)) * HTB)
#define PG8_SB(b, h) ((4 + (b) * 2 + (h)) * HTB)
#define PG8_STAGE(bufoff, gbase, voff) do { _Pragma("unroll") for (int _i = 0; _i < 2; ++_i) \
        __builtin_amdgcn_global_load_lds((const unsigned*)((const char*)(gbase) + (voff)[_i]), (PG8_LAS unsigned*)(lds + (bufoff) + ldsw + _i * 8192), 16, 0, 0); } while (0)
#define PG8_LDA(dst, b, h) do { _Pragma("unroll") for (int m = 0; m < 4; ++m) _Pragma("unroll") for (int k = 0; k < 2; ++k) dst[m][k] = *(const PG8_LAS bf16x8*)(lds + PG8_SA(b, h) + aoff + m * 2048 + k * 1024); } while (0)
#define PG8_LDB(dst, b, h) do { _Pragma("unroll") for (int n = 0; n < 2; ++n) _Pragma("unroll") for (int k = 0; k < 2; ++k) dst[n][k] = *(const PG8_LAS bf16x8*)(lds + PG8_SB(b, h) + boff + n * 2048 + k * 1024); } while (0)
#define PG8_MMA(ai, bj, At, Bt) do { __builtin_amdgcn_s_setprio(1); _Pragma("unroll") for (int m = 0; m < 4; ++m) _Pragma("unroll") for (int n = 0; n < 2; ++n) _Pragma("unroll") for (int k = 0; k < 2; ++k) \
        acc[ai][bj][m][n] = __builtin_amdgcn_mfma_f32_16x16x32_bf16(Bt[n][k], At[m][k], acc[ai][bj][m][n], 0, 0, 0); __builtin_amdgcn_s_setprio(0); } while (0)
#define PG8_WAIT_V(n) asm volatile("s_waitcnt vmcnt(" #n ")" ::: "memory")
#define PG8_WAIT_L(n) asm volatile("s_waitcnt lgkmcnt(" #n ")" ::: "memory")
#define PG8_BAR __builtin_amdgcn_s_barrier()
#define PG8_SCHED __builtin_amdgcn_sched_barrier(0)
    Unit cur, nxt; int ui = 0;
    if (!S.next(0, cur)) return;
    f32x4 acc[2][2][4][2];
#pragma unroll
    for (int a = 0; a < 2; ++a)
#pragma unroll
        for (int b = 0; b < 2; ++b)
#pragma unroll
            for (int m = 0; m < 4; ++m)
#pragma unroll
                for (int n = 0; n < 2; ++n) acc[a][b][m][n] = (f32x4){0.f, 0.f, 0.f, 0.f};
    bf16x8 At[4][2], B0[2][2], B1[2][2];
    const char* cA = (const char*)g.A + (size_t)cur.pm * tstepA; const char* cB = (const char*)g.Bt + (size_t)cur.pn * tstepB;
    S.a_ready(cur);
    if constexpr (SP2) {
        PG8_STAGE(PG8_SB(0, 0), cB, voffB); PG8_STAGE(PG8_SB(0, 1), cB + hstepB, voffB); PG8_STAGE(PG8_SA(0, 0), cA, voffA); PG8_STAGE(PG8_SA(0, 1), cA + hstepA, voffA);
        if (wr == 1) PG8_BAR;
        PG8_WAIT_V(2); PG8_BAR;
        PG8_STAGE(PG8_SB(1, 0), cB + kstep, voffB); PG8_STAGE(PG8_SA(1, 0), cA + kstep, voffA); PG8_STAGE(PG8_SB(1, 1), cB + hstepB + kstep, voffB);
        PG8_WAIT_V(6); PG8_BAR;
    } else {
        PG8_STAGE(PG8_SB(0, 0), cB, voffB); PG8_STAGE(PG8_SA(0, 0), cA, voffA); PG8_STAGE(PG8_SB(0, 1), cB + hstepB, voffB); PG8_STAGE(PG8_SA(0, 1), cA + hstepA, voffA);
        if (wr == 1) PG8_BAR;
        PG8_WAIT_V(4); PG8_BAR;
        PG8_STAGE(PG8_SB(1, 0), cB + kstep, voffB); PG8_STAGE(PG8_SA(1, 0), cA + kstep, voffA); PG8_STAGE(PG8_SB(1, 1), cB + hstepB + kstep, voffB);
        PG8_WAIT_V(6); PG8_BAR;
    }
    for (;;) {
        const bool has_next = S.next(ui + 1, nxt);
        const char* nA = has_next ? (const char*)g.A + (size_t)nxt.pm * tstepA : cA; const char* nB = has_next ? (const char*)g.Bt + (size_t)nxt.pn * tstepB : cB;
        for (int t = 0; t < nt; t += 2) {
            const bool last = (t == nt - 2);
            const char* a1 = cA + (size_t)(t + 1) * kstep;
            const char* a2 = last ? nA : cA + (size_t)(t + 2) * kstep; const char* b2 = last ? nB : cB + (size_t)(t + 2) * kstep;
            const char* a3 = a2 + kstep; const char* b3 = b2 + kstep;
            if (last && has_next) S.a_ready(nxt);
            if constexpr (SP2) {
            PG8_LDB(B0, 0, 0); PG8_LDB(B1, 0, 1); PG8_SCHED; PG8_LDA(At, 0, 0); PG8_STAGE(PG8_SA(1, 1), a1 + hstepA, voffA);
            PG8_WAIT_V(8); PG8_WAIT_L(0); PG8_BAR; PG8_MMA(0, 0, At, B0); PG8_MMA(0, 1, At, B1); PG8_BAR; PG8_SCHED;
            PG8_LDA(At, 0, 1); PG8_STAGE(PG8_SB(0, 0), b2, voffB); PG8_STAGE(PG8_SB(0, 1), b2 + hstepB, voffB); PG8_STAGE(PG8_SA(0, 0), a2, voffA);
            PG8_WAIT_V(8); PG8_WAIT_L(0); PG8_BAR; PG8_MMA(1, 0, At, B0); PG8_MMA(1, 1, At, B1); PG8_BAR; PG8_SCHED;
            PG8_LDB(B0, 1, 0); PG8_LDB(B1, 1, 1); PG8_SCHED; PG8_LDA(At, 1, 0); PG8_STAGE(PG8_SA(0, 1), a2 + hstepA, voffA);
            PG8_WAIT_V(8); PG8_WAIT_L(0); PG8_BAR; PG8_MMA(0, 0, At, B0); PG8_MMA(0, 1, At, B1); PG8_BAR; PG8_SCHED;
            PG8_LDA(At, 1, 1); PG8_STAGE(PG8_SB(1, 0), b3, voffB); PG8_STAGE(PG8_SB(1, 1), b3 + hstepB, voffB); PG8_STAGE(PG8_SA(1, 0), a3, voffA);
            PG8_WAIT_V(8); PG8_WAIT_L(0); PG8_BAR; PG8_MMA(1, 0, At, B0); PG8_MMA(1, 1, At, B1); PG8_BAR; PG8_SCHED;
            } else {
            PG8_LDB(B0, 0, 0); PG8_SCHED; PG8_LDA(At, 0, 0); PG8_STAGE(PG8_SA(1, 1), a1 + hstepA, voffA);
            PG8_WAIT_L(8); PG8_BAR; PG8_WAIT_L(0); PG8_MMA(0, 0, At, B0); PG8_BAR; PG8_SCHED;
            PG8_LDB(B1, 0, 1); PG8_STAGE(PG8_SB(0, 0), b2, voffB);
            PG8_BAR; PG8_WAIT_L(0); PG8_MMA(0, 1, At, B1); PG8_BAR;
            PG8_LDA(At, 0, 1); PG8_STAGE(PG8_SA(0, 0), a2, voffA);
            PG8_BAR; PG8_WAIT_L(0); PG8_MMA(1, 0, At, B0); PG8_BAR; PG8_SCHED;
            PG8_STAGE(PG8_SB(0, 1), b2 + hstepB, voffB);
            PG8_WAIT_V(6); PG8_BAR; PG8_MMA(1, 1, At, B1); PG8_BAR;
            PG8_LDB(B0, 1, 0); PG8_SCHED; PG8_LDA(At, 1, 0); PG8_STAGE(PG8_SA(0, 1), a2 + hstepA, voffA);
            PG8_WAIT_L(8); PG8_BAR; PG8_WAIT_L(0); PG8_MMA(0, 0, At, B0); PG8_BAR; PG8_SCHED;
            PG8_LDB(B1, 1, 1); PG8_STAGE(PG8_SB(1, 0), b3, voffB);
            PG8_BAR; PG8_WAIT_L(0); PG8_MMA(0, 1, At, B1); PG8_BAR;
            PG8_LDA(At, 1, 1); PG8_STAGE(PG8_SA(1, 0), a3, voffA);
            PG8_BAR; PG8_WAIT_L(0); PG8_MMA(1, 0, At, B0); PG8_BAR; PG8_SCHED;
            PG8_STAGE(PG8_SB(1, 1), b3 + hstepB, voffB);
            PG8_WAIT_V(6); PG8_BAR; PG8_MMA(1, 1, At, B1); PG8_BAR;
            }
        }
        if constexpr (ALIGN_EPI) { if (wr == 0) PG8_BAR; }
        if constexpr (!Epi::AFTER_DRAIN) { E(acc, cur, wr, wc, fr, fq); S.done(cur); }
        if (!has_next) break;
#pragma unroll
        for (int a = 0; a < 2; ++a)
#pragma unroll
            for (int b = 0; b < 2; ++b)
#pragma unroll
                for (int m = 0; m < 4; ++m)
#pragma unroll
                    for (int n = 0; n < 2; ++n) acc[a][b][m][n] = (f32x4){0.f, 0.f, 0.f, 0.f};
        cur = nxt; cA = nA; cB = nB; ++ui;
        if constexpr (ALIGN_EPI) { if (wr == 1) PG8_BAR; }
    }
    PG8_WAIT_V(0);
    if constexpr (!ALIGN_EPI) { if (wr == 0) PG8_BAR; }
    PG8_BAR;
    if constexpr (Epi::AFTER_DRAIN) { E.fused(acc, cur, wr, wc, fr, fq, lds, wid, lane); S.done(cur); }
#undef PG8_SA
#undef PG8_SB
#undef PG8_STAGE
#undef PG8_LDA
#undef PG8_LDB
#undef PG8_MMA
#undef PG8_WAIT_V
#undef PG8_WAIT_L
#undef PG8_BAR
#undef PG8_SCHED
}
}

#define LAS __attribute__((address_space(3)))
typedef unsigned short bf16_t;
typedef short bf16x8 __attribute__((ext_vector_type(8)));
typedef short s16x4 __attribute__((ext_vector_type(4)));
typedef float f32x4 __attribute__((ext_vector_type(4)));
typedef float f32x16 __attribute__((ext_vector_type(16)));
typedef unsigned u32x4 __attribute__((ext_vector_type(4)));
typedef unsigned u32x2 __attribute__((ext_vector_type(2)));
typedef float f32x2 __attribute__((ext_vector_type(2)));

constexpr int SEQ = 8192, DM = 2048, DFF = 8192, NIN = 4678, NINP = 4864, NQUP = 1152, NQUPP = 1280, NKVUP = 1536;
constexpr int C_DQ = 0, C_DK = 512, C_DV = 1024, C_FQ = 1536, C_FK = 2304, C_FV = 3072, C_MQ = 3840, C_CKV = 4352, C_KR = 4608, C_FF = 4672;
constexpr size_t MiB = 1u << 20;
constexpr size_t WS_CNT = 0, WS_LAM = 128, WS_TABLE = 4096, WS_BAR = 16384, WS_SSQ = 64 * 1024, WS_LOGF = 256 * 1024, WS_CUM = 512 * 1024;
constexpr size_t WS_COSP = 1 * MiB, WS_SINP = 1 * MiB + 256 * 1024, WS_COSM = 2 * MiB, WS_SINM = 3 * MiB;
constexpr size_t WS_WIN = 4 * MiB, SZ_WIN = 19 * MiB, WS_WOUT = 42 * MiB, SZ_WOUT = 8 * MiB, WS_WUP = 58 * MiB, SZ_WUP = 32 * MiB, WS_WDN = 122 * MiB, SZ_WDN = 32 * MiB;
constexpr size_t WS_WQUP = 186 * MiB, SZ_WQUP = (size_t)NQUPP * 512 * 2, WS_WKVUP = 189 * MiB, SZ_WKVUP = (size_t)NKVUP * 256 * 2;
constexpr size_t WS_XB = 192 * MiB, WS_XF = 224 * MiB, WS_MIX = 288 * MiB, WS_PROJ = 320 * MiB, WS_QC = 396 * MiB, WS_KVC = 416 * MiB, WS_H = 320 * MiB, WS_END = 448 * MiB;
#ifndef ATT_SPLIT
#define ATT_SPLIT 0
#endif
constexpr int NUNITS = ATT_SPLIT ? 1024 : 640;
constexpr int LDS_BYTES = 131072 + 4096;
constexpr float LOG2E = 1.4426950408889634f;

struct Args {
    const float* in[23];
    float* out; unsigned char* ws;
    int ph_lo, ph_hi;
};
typedef const __attribute__((address_space(4))) Args* ArgsP;
enum { I_X = 0, I_NORM_MIX, I_W_IN, I_DQN, I_DKN, I_LQ1, I_LK1, I_LQ2, I_LK2, I_SUBLN, I_FQN, I_FKN, I_FBIAS, I_QAN, I_KVAN, I_WQUP, I_WKVUP, I_MQN, I_MKN, I_WOUT, I_NORM_FFN, I_WUP, I_WDN };

typedef float cvt_f32x2 __attribute__((ext_vector_type(2))); typedef __bf16 cvt_bf16x2 __attribute__((ext_vector_type(2)));
__device__ __forceinline__ unsigned cvtpk(float lo, float hi) { const cvt_f32x2 v = {lo, hi}; const cvt_bf16x2 r = __builtin_convertvector(v, cvt_bf16x2); return __builtin_bit_cast(unsigned, r); }
__device__ __forceinline__ float bflo(unsigned w) { return __uint_as_float(w << 16); }
__device__ __forceinline__ float bfhi(unsigned w) { return __uint_as_float(w & 0xffff0000u); }
__device__ __forceinline__ float wave_sum(float v) {
#pragma unroll
    for (int o = 1; o < 64; o <<= 1) v += __shfl_xor(v, o);
    return v;
}

#define XB_TMO      128
#define XB_XCNT(j)  (256  + 64 * (j))
#define XB_XSUB(j)  (1280 + 64 * (j))
#define XB_XGEN(j)  (2304 + 64 * (j))
#define XB_TOP      3328
#define XB_TOPGEN   3392
#define XCD_BAR_WORDS 3456
#define XB_SPIN_CAP (1u << 18)

__device__ __forceinline__ unsigned xb_ld(unsigned* p)              { return __hip_atomic_load(p, __ATOMIC_RELAXED, __HIP_MEMORY_SCOPE_AGENT); }
__device__ __forceinline__ unsigned xb_add(unsigned* p, unsigned v) { return __hip_atomic_fetch_add(p, v, __ATOMIC_RELAXED, __HIP_MEMORY_SCOPE_AGENT); }
__device__ __forceinline__ unsigned xb_xcc_id() { return (unsigned)__builtin_amdgcn_s_getreg((3 << 11) | 20) & 0xFu; }
#define XB_SPIN(cond, bar) do { unsigned _sp = 0; while (cond) { __builtin_amdgcn_s_sleep(1); \
    if ((++_sp & 255u) == 0u) { if (xb_ld(&(bar)[XB_TMO])) break; if (_sp > XB_SPIN_CAP) { atomicAdd(&(bar)[XB_TMO], 1u); break; } } } } while (0)

struct XcdBarrier {
    unsigned* bar; unsigned x;
    volatile LAS unsigned* st;
};

__device__ __forceinline__ XcdBarrier xcd_barrier_post(unsigned* bar, volatile LAS unsigned* st) {
    XcdBarrier b; b.bar = bar; b.x = xb_xcc_id(); b.st = st;
    if (threadIdx.x == 0) (void)xb_add(&bar[XB_XCNT(b.x)], 1u);
    return b;
}
__device__ __forceinline__ void xcd_barrier_complete(unsigned* bar, unsigned x, unsigned& nloc, unsigned& nx) {
    const unsigned G = gridDim.x * gridDim.y * gridDim.z;
    unsigned sum, cnt, mine, sp = 0u;
    for (;;) {
        sum = 0u; cnt = 0u; mine = 0u;
#pragma unroll
        for (unsigned j = 0; j < 16; ++j) { const unsigned c = xb_ld(&bar[XB_XCNT(j)]); sum += c; cnt += (c > 0u) ? 1u : 0u; mine = (j == x) ? c : mine; }
        if (sum == G) break;
        __builtin_amdgcn_s_sleep(1);
        if ((++sp & 255u) == 0u) { if (xb_ld(&bar[XB_TMO])) break; if (sp > XB_SPIN_CAP) { atomicAdd(&bar[XB_TMO], 1u); break; } }
    }
    nloc = mine > 0u ? mine : 1u; nx = cnt > 0u ? cnt : 1u;
}

__device__ __forceinline__ void xcd_barrier(const XcdBarrier& b) {
    asm volatile("s_waitcnt vmcnt(0)" ::: "memory");
    __syncthreads();
    if (threadIdx.x == 0) {
        unsigned* bar = b.bar;
        __builtin_amdgcn_s_waitcnt(0);
        unsigned nloc = b.st[0], nx = b.st[1];
        if (nloc == 0u) { xcd_barrier_complete(bar, b.x, nloc, nx); b.st[0] = nloc; b.st[1] = nx; }
        const unsigned old = xb_add(&bar[XB_XSUB(b.x)], 1u);
        const unsigned gen = old / nloc;
        if (old + 1u == (gen + 1u) * nloc) {
            __builtin_amdgcn_fence(__ATOMIC_RELEASE, "agent");
            asm volatile("s_waitcnt vmcnt(0)" ::: "memory");
            const unsigned og = xb_add(&bar[XB_TOP], 1u);
            const unsigned tg = og / nx;
            if (og + 1u == (tg + 1u) * nx) xb_add(&bar[XB_TOPGEN], 1u);
            else XB_SPIN(xb_ld(&bar[XB_TOPGEN]) == tg, bar);
            __builtin_amdgcn_fence(__ATOMIC_ACQUIRE, "agent");
            xb_add(&bar[XB_XGEN(b.x)], 1u);
            asm volatile("s_waitcnt vmcnt(0)" ::: "memory");
        } else {
            XB_SPIN(xb_ld(&bar[XB_XGEN(b.x)]) == gen, bar);
            __builtin_amdgcn_fence(__ATOMIC_ACQUIRE, "agent");
            asm volatile("s_waitcnt vmcnt(0)" ::: "memory");
        }
    }
    __syncthreads();
}


template <int MAP>
__device__ __forceinline__ void tr_item(const float* __restrict__ W, int K, int N, const float* __restrict__ gain, bf16_t* WT, LAS float* scr, int item, int lane) {
    const int nblk = (N + 31) / 32, kb = item / nblk, nb = item % nblk, k0 = 64 * kb, n0 = 32 * nb;
    const int nsrc = n0 + (lane & 31); const bool ok = nsrc < N;
    float v[32];
#pragma unroll
    for (int i = 0; i < 32; ++i) { const int kk = 2 * i + (lane >> 5); v[i] = ok ? __builtin_nontemporal_load(W + (size_t)(k0 + kk) * N + nsrc) : 0.f; }
#pragma unroll
    for (int i = 0; i < 32; ++i) { const int kk = 2 * i + (lane >> 5); float x = v[i]; if (gain) x *= gain[k0 + kk]; scr[kk * 33 + (lane & 31)] = x; }
    asm volatile("s_waitcnt lgkmcnt(0)" ::: "memory");
    const int c = lane & 7;
#pragma unroll
    for (int j = 0; j < 4; ++j) {
        const int nl = (lane >> 3) + 8 * j, n = n0 + nl;
        const LAS float* s = scr + (8 * c) * 33 + nl;
        u32x4 o; o.x = cvtpk(s[0 * 33], s[1 * 33]); o.y = cvtpk(s[2 * 33], s[3 * 33]); o.z = cvtpk(s[4 * 33], s[5 * 33]); o.w = cvtpk(s[6 * 33], s[7 * 33]);
        int dest = n;
        if (MAP == 1) { if (n >= 3846) dest = n - 6; else if (n >= 3840) dest = C_FF + (n - 3840); }
        if (n < N) *(u32x4*)(WT + (size_t)dest * K + k0 + 8 * c) = o;
    }
    asm volatile("s_waitcnt lgkmcnt(0)" ::: "memory");
}

constexpr int TR_IT_IN = (DM / 64) * ((NIN + 31) / 32), TR_IT_OUT = (DM / 64) * (DM / 32), TR_IT_UP = (DM / 64) * (DFF / 32), TR_IT_DN = (DFF / 64) * (DM / 32);
constexpr int TR_IT_QUP = (512 / 64) * (NQUP / 32), TR_IT_KVUP = (256 / 64) * (NKVUP / 32);
constexpr int TR_PER_L = TR_IT_IN + TR_IT_OUT + TR_IT_UP + TR_IT_DN + TR_IT_QUP + TR_IT_KVUP;
constexpr int TR_CHUNK = 32;
constexpr int TR_N_EARLY = TR_IT_IN + TR_IT_QUP + TR_IT_KVUP, TR_N_LATE = TR_IT_OUT + TR_IT_UP + TR_IT_DN;
__device__ __forceinline__ int tr_early_item(int i) { return i < TR_IT_IN ? i : i + TR_N_LATE; }
__device__ __forceinline__ int tr_late_item(int i) { return i + TR_IT_IN; }
__device__ __forceinline__ void tr_dispatch(ArgsP a, int l, int r, LAS float* scr, int lane) {
    unsigned char* ws = a->ws;
    if (r < TR_IT_IN) { tr_item<1>(a->in[I_W_IN] + (size_t)l * DM * NIN, DM, NIN, a->in[I_NORM_MIX] + l * DM, (bf16_t*)(ws + WS_WIN + l * SZ_WIN), scr, r, lane); return; } r -= TR_IT_IN;
    if (r < TR_IT_OUT) { tr_item<0>(a->in[I_WOUT] + (size_t)l * DM * DM, DM, DM, nullptr, (bf16_t*)(ws + WS_WOUT + l * SZ_WOUT), scr, r, lane); return; } r -= TR_IT_OUT;
    if (r < TR_IT_UP) { tr_item<0>(a->in[I_WUP] + (size_t)l * DM * DFF, DM, DFF, a->in[I_NORM_FFN] + l * DM, (bf16_t*)(ws + WS_WUP + l * SZ_WUP), scr, r, lane); return; } r -= TR_IT_UP;
    if (r < TR_IT_DN) { tr_item<0>(a->in[I_WDN] + (size_t)l * DFF * DM, DFF, DM, nullptr, (bf16_t*)(ws + WS_WDN + l * SZ_WDN), scr, r, lane); return; } r -= TR_IT_DN;
    if (r < TR_IT_QUP) { tr_item<0>(a->in[I_WQUP] + (size_t)l * 512 * NQUP, 512, NQUP, a->in[I_QAN] + l * 512, (bf16_t*)(ws + WS_WQUP + l * SZ_WQUP), scr, r, lane); return; } r -= TR_IT_QUP;
    tr_item<0>(a->in[I_WKVUP] + (size_t)l * 256 * NKVUP, 256, NKVUP, a->in[I_KVAN] + l * 256, (bf16_t*)(ws + WS_WKVUP + l * SZ_WKVUP), scr, r, lane);
}
__device__ __forceinline__ void prologue(ArgsP a, LAS unsigned char* lds) {
    int tid_ = threadIdx.x; asm volatile("" : "+v"(tid_));
    const int tid = tid_, lane = tid & 63, wave = __builtin_amdgcn_readfirstlane(tid >> 6);
    const int G = gridDim.x, gw = blockIdx.x * 8 + wave, NGW = G * 8;
    unsigned char* ws = a->ws;
    if (blockIdx.x == 0) {
        if (tid < 32) ((int*)(ws + WS_CNT))[tid] = 0;
        if (tid >= 64 && tid < 66) {
            const int l = tid - 64; float s1 = 0.f, s2 = 0.f;
            for (int i = 0; i < 64; ++i) { s1 += a->in[I_LQ1][l * 64 + i] * a->in[I_LK1][l * 64 + i]; s2 += a->in[I_LQ2][l * 64 + i] * a->in[I_LK2][l * 64 + i]; }
            const float linit = 0.8f - 0.6f * expf(-0.3f * (float)l);
            ((float*)(ws + WS_LAM))[l] = expf(s1) - expf(s2) + linit;
        }
        if (tid >= 66 && tid < 68) {
            const int l = tid - 66; float gq = 0.f, gk = 0.f;
            for (int i = 0; i < 128; ++i) { gq = fmaxf(gq, fabsf(a->in[I_FQN][l * 128 + i])); gk = fmaxf(gk, fabsf(a->in[I_FKN][l * 128 + i])); }
            ((float*)(ws + WS_LAM))[8 + l] = 11.3137085f * gq * gk * 1.4426950408889634f * 1.02f;
        }
        if (tid >= 68 && tid < 70) {
            const int l = tid - 68; float gq = 0.f, gk = 0.f, qr_ = 0.f, qn = 0.f, kr = 0.f, kn = 0.f;
            for (int i = 0; i < 64; ++i) { gq = fmaxf(gq, fabsf(a->in[I_DQN][l * 64 + i])); gk = fmaxf(gk, fabsf(a->in[I_DKN][l * 64 + i])); }
            ((float*)(ws + WS_LAM))[12 + l] = 8.0f * gq * gk * 1.4426950408889634f * 1.02f;
            for (int i = 0; i < 64; ++i) { qr_ = fmaxf(qr_, fabsf(a->in[I_MQN][l * 192 + i])); kr = fmaxf(kr, fabsf(a->in[I_MKN][l * 192 + i])); }
            for (int i = 64; i < 192; ++i) { qn = fmaxf(qn, fabsf(a->in[I_MQN][l * 192 + i])); kn = fmaxf(kn, fabsf(a->in[I_MKN][l * 192 + i])); }
            ((float*)(ws + WS_LAM))[16 + l] = sqrtf(64.f * qr_ * qr_ + 128.f * qn * qn) * sqrtf(64.f * kr * kr + 128.f * kn * kn) * 0.07216878364870322f * 1.4426950408889634f * 1.02f;
        }
        for (int id = tid; id < NUNITS; id += 512) {
            auto cost = [](int u) { constexpr int Q = ATT_SPLIT ? 64 : 32, NB = 256 + 6 * Q;
                                    return u < 256 ? 48 * ((u & 63) + 1) : (u < NB ? (ATT_SPLIT ? 16 : 64) * (((u - 256) % Q) + 1) : (ATT_SPLIT ? 40 : 160) * (((u - NB) % Q) + 1)); };
            const int mine = cost(id); int rank = 0;
            for (int j = 0; j < NUNITS; ++j) { const int cj = cost(j); rank += (cj > mine || (cj == mine && j < id)) ? 1 : 0; }
            ((int*)(ws + WS_TABLE))[rank] = id;
        }
    }
    {
        float* cosp = (float*)(ws + WS_COSP); float* sinp = (float*)(ws + WS_SINP); float* cosm = (float*)(ws + WS_COSM); float* sinm = (float*)(ws + WS_SINM);
        const int gt = blockIdx.x * 512 + tid, NT = G * 512;
        for (int i = gt; i < SEQ * 40; i += NT) {
            const int pos = i / 40, j = i % 40;
            if (j < 8) { const float inv = (float)pow(500000.0, -(double)j / 8.0); const float ang = (float)pos * inv; cosp[pos * 8 + j] = (float)cos((double)ang); sinp[pos * 8 + j] = (float)sin((double)ang); }
            else { const int jj = j - 8; const float inv = (float)pow(500000.0, -(double)jj / 32.0); const float ang = (float)pos * inv; cosm[pos * 32 + jj] = (float)cos((double)ang); sinm[pos * 32 + jj] = (float)sin((double)ang); }
        }
    }
    {
        const float* x = a->in[I_X]; bf16_t* xb = (bf16_t*)(ws + WS_XB); float* ssq = (float*)(ws + WS_SSQ);
        for (int m = gw; m < SEQ; m += NGW) {
            const f32x4* xr = (const f32x4*)(x + (size_t)m * DM) + lane; u32x2* o = (u32x2*)(xb + (size_t)m * DM) + lane; float s = 0.f;
#pragma unroll
            for (int j = 0; j < 8; ++j) { const f32x4 v = __builtin_nontemporal_load(xr + 64 * j); s += (v[0] * v[0] + v[1] * v[1]) + (v[2] * v[2] + v[3] * v[3]); u32x2 w; w.x = cvtpk(v[0], v[1]); w.y = cvtpk(v[2], v[3]); o[64 * j] = w; }
            s = wave_sum(s);
            if (lane == 0) ssq[m] = s;
            if (lane >= 1 && lane < 4) ssq[lane * SEQ + m] = 0.f;
        }
    }
    {
        LAS float* scr = (LAS float*)(lds + wave * 8704);
        for (int it = gw; it < TR_N_EARLY; it += NGW) tr_dispatch(a, 0, tr_early_item(it), scr, lane);
    }
}

__device__ __forceinline__ void unpack8(const u32x4 w, float* f) { f[0] = bflo(w.x); f[1] = bfhi(w.x); f[2] = bflo(w.y); f[3] = bfhi(w.y); f[4] = bflo(w.z); f[5] = bfhi(w.z); f[6] = bflo(w.w); f[7] = bfhi(w.w); }
__device__ __forceinline__ u32x4 pack8f(const float* f) { u32x4 w; w.x = cvtpk(f[0], f[1]); w.y = cvtpk(f[2], f[3]); w.z = cvtpk(f[4], f[5]); w.w = cvtpk(f[6], f[7]); return w; }

__device__ __forceinline__ void post_proj_row(ArgsP a, int l, int row, int lane) {
    unsigned char* ws = a->ws;
    bf16_t* P = (bf16_t*)(ws + WS_PROJ) + (size_t)row * NINP;
    const u32x4 ld_d0 = *(const u32x4*)(P + 16 * lane), ld_d1 = *(const u32x4*)(P + 16 * lane + 8);
    const u32x4 ld_f0 = *(const u32x4*)(P + C_FQ + 8 * lane), ld_f1 = *(const u32x4*)(P + C_FQ + 512 + 8 * lane), ld_f2 = *(const u32x4*)(P + C_FQ + 1024 + 8 * lane);
    const u32x4 ld_q = *(const u32x4*)(P + C_MQ + 8 * lane);
    const u32x2 ld_c = *(const u32x2*)(P + C_CKV + 4 * lane);
    const u32x4 ld_k = *(const u32x4*)(P + C_KR + 8 * (lane & 7));
    const unsigned short ld_ff = P[C_FF + (lane < 6 ? lane : 0)];
    {
        float x[16]; unpack8(ld_d0, x); unpack8(ld_d1, x + 8);
        float ss = 0.f;
#pragma unroll
        for (int i = 0; i < 16; ++i) ss += x[i] * x[i];
        ss += __shfl_xor(ss, 1); ss += __shfl_xor(ss, 2);
        const float rstd = rsqrtf(ss * (1.0f / 64.0f) + RMS_EPS);
        const float* g = (lane < 32 ? a->in[I_DQN] : a->in[I_DKN]) + l * 64 + (lane & 3) * 16;
        const float rq = rstd;
#pragma unroll
        for (int i = 0; i < 16; ++i) x[i] = x[i] * rq * g[i];
        if ((lane & 3) == 0) {
            const float* cp = (const float*)(ws + WS_COSP) + row * 8; const float* sp = (const float*)(ws + WS_SINP) + row * 8;
#pragma unroll
            for (int i = 0; i < 8; ++i) { const float x1 = x[i], x2 = x[i + 8], c = cp[i], s = sp[i]; x[i] = x1 * c - x2 * s; x[i + 8] = x2 * c + x1 * s; }
        }
        *(u32x4*)(P + 16 * lane) = pack8f(x); *(u32x4*)(P + 16 * lane + 8) = pack8f(x + 8);
    }
#pragma unroll
    for (int p = 0; p < 3; ++p) {
        const int rel = 512 * p + 8 * lane;
        float x[8]; unpack8(p == 0 ? ld_f0 : (p == 1 ? ld_f1 : ld_f2), x);
        float ss = 0.f;
#pragma unroll
        for (int i = 0; i < 8; ++i) ss += x[i] * x[i];
        ss += __shfl_xor(ss, 1); ss += __shfl_xor(ss, 2); ss += __shfl_xor(ss, 4); ss += __shfl_xor(ss, 8);
        const float rstd = rsqrtf(ss * (1.0f / 128.0f) + RMS_EPS);
        const float* g = (rel < 768 ? a->in[I_FQN] : a->in[I_FKN]) + l * 128 + (rel & 127);
        const float rq = rstd;
#pragma unroll
        for (int i = 0; i < 8; ++i) x[i] = x[i] * rq * g[i];
        *(u32x4*)(P + C_FQ + rel) = pack8f(x);
    }
    {
        float x[8]; unpack8(ld_q, x);
        float ss = 0.f;
#pragma unroll
        for (int i = 0; i < 8; ++i) ss += x[i] * x[i];
        ss = wave_sum(ss);
        const float rstd = rsqrtf(ss * (1.0f / 512.0f) + RMS_EPS);
#pragma unroll
        for (int i = 0; i < 8; ++i) x[i] *= rstd;
        *(u32x4*)(P + C_MQ + 8 * lane) = pack8f(x);
    }
    {
        const u32x2 w0 = ld_c;
        float x0 = bflo(w0.x), x1 = bfhi(w0.x), x2 = bflo(w0.y), x3 = bfhi(w0.y);
        float ss = wave_sum((x0 * x0 + x1 * x1) + (x2 * x2 + x3 * x3));
        const float rstd = rsqrtf(ss * (1.0f / 256.0f) + RMS_EPS);
        u32x2 o; o.x = cvtpk(x0 * rstd, x1 * rstd); o.y = cvtpk(x2 * rstd, x3 * rstd);
        *(u32x2*)(P + C_CKV + 4 * lane) = o;
    }
    {
        const int j = lane & 7;
        float x[8]; unpack8(ld_k, x);
        float ss = 0.f;
#pragma unroll
        for (int i = 0; i < 8; ++i) ss += x[i] * x[i];
        ss += __shfl_xor(ss, 1); ss += __shfl_xor(ss, 2); ss += __shfl_xor(ss, 4);
        const float rstd = rsqrtf(ss * (1.0f / 64.0f) + RMS_EPS);
        const float* g = a->in[I_MKN] + l * 192 + 8 * j;
        const float* cp = (const float*)(ws + WS_COSM) + row * 32 + 8 * (j & 3); const float* sp = (const float*)(ws + WS_SINM) + row * 32 + 8 * (j & 3);
        float y[8];
#pragma unroll
        for (int i = 0; i < 8; ++i) {
            const float mine = x[i] * rstd * g[i]; const float other = __shfl_xor(mine, 4);
            y[i] = (j < 4) ? (mine * cp[i] - other * sp[i]) : (mine * cp[i] + other * sp[i]);
        }
        if (lane < 8) *(u32x4*)(P + C_KR + 8 * j) = pack8f(y);
    }
    if (lane < 6) {
        const float z = __uint_as_float((unsigned)ld_ff << 16) + a->in[I_FBIAS][l * 6 + lane];
        const float lf = fminf(z, 0.f) - log1pf(expf(-fabsf(z)));
        ((float*)(ws + WS_LOGF))[row * 8 + lane] = lf;
    }
}

__device__ __forceinline__ void fox_cumsum(ArgsP a, int h, LAS unsigned char* lds) {
    int tid_ = threadIdx.x; asm volatile("" : "+v"(tid_));
    const int tid = tid_, lane = tid & 63, wave = tid >> 6;
    const float* lf = (const float*)(a->ws + WS_LOGF); float* cum = (float*)(a->ws + WS_CUM);
    double v[16]; double loc = 0.0;
#pragma unroll
    for (int i = 0; i < 16; ++i) { loc += (double)lf[(16 * tid + i) * 8 + h]; v[i] = loc; }
    double inc = loc;
#pragma unroll
    for (int o = 1; o < 64; o <<= 1) { const double t = __shfl_up(inc, o); if (lane >= o) inc += t; }
    LAS double* wt = (LAS double*)lds;
    if (lane == 63) wt[wave] = inc;
    __syncthreads();
    double pre = inc - loc;
    for (int w = 0; w < wave; ++w) pre += wt[w];
#pragma unroll
    for (int i = 0; i < 16; ++i) cum[(16 * tid + i) * 8 + h] = (float)((pre + v[i]) * 1.4426950408889634);
    __syncthreads();
}

__device__ __forceinline__ void post_mla_row(ArgsP a, int l, int row, int lane) {
    unsigned char* ws = a->ws;
    bf16_t* Q = (bf16_t*)(ws + WS_QC) + (size_t)row * NQUPP;
    bf16_t* KV = (bf16_t*)(ws + WS_KVC) + (size_t)row * NKVUP;
    const int g_r = (lane >> 3) < 6 ? (lane >> 3) : 0;
    const u32x4 ld_r = *(const u32x4*)(Q + g_r * 192 + 8 * (lane & 7));
    const int g_n0 = lane >> 4, g_n1 = (4 + (lane >> 4)) < 6 ? 4 + (lane >> 4) : 0;
    const u32x4 ld_qn0 = *(const u32x4*)(Q + g_n0 * 192 + 64 + 8 * (lane & 15)), ld_qn1 = *(const u32x4*)(Q + g_n1 * 192 + 64 + 8 * (lane & 15));
    const u32x4 ld_kn0 = *(const u32x4*)(KV + g_n0 * 256 + 8 * (lane & 15)), ld_kn1 = *(const u32x4*)(KV + g_n1 * 256 + 8 * (lane & 15));
    {
        const int g = lane >> 3, j = lane & 7; const bool act = g < 6;
        float x[8]; unpack8(ld_r, x);
        float ss = 0.f;
#pragma unroll
        for (int i = 0; i < 8; ++i) ss += x[i] * x[i];
        ss += __shfl_xor(ss, 1); ss += __shfl_xor(ss, 2); ss += __shfl_xor(ss, 4);
        const float rstd = rsqrtf(ss * (1.0f / 64.0f) + RMS_EPS);
        const float* gn = a->in[I_MQN] + l * 192 + 8 * j;
        const float* cp = (const float*)(ws + WS_COSM) + row * 32 + 8 * (j & 3); const float* sp = (const float*)(ws + WS_SINM) + row * 32 + 8 * (j & 3);
        float y[8];
#pragma unroll
        for (int i = 0; i < 8; ++i) {
            const float mine = x[i] * rstd * gn[i]; const float other = __shfl_xor(mine, 4);
            y[i] = (j < 4) ? (mine * cp[i] - other * sp[i]) : (mine * cp[i] + other * sp[i]);
        }
        if (act) *(u32x4*)(Q + g * 192 + 8 * j) = pack8f(y);
    }
#pragma unroll
    for (int p = 0; p < 2; ++p) {
        const int g = 4 * p + (lane >> 4), j = lane & 15; const bool act = g < 6; const int gg = act ? g : 0;
        {
            bf16_t* ptr = Q + gg * 192 + 64 + 8 * j;
            float x[8]; unpack8(p == 0 ? ld_qn0 : ld_qn1, x);
            float ss = 0.f;
#pragma unroll
            for (int i = 0; i < 8; ++i) ss += x[i] * x[i];
            ss += __shfl_xor(ss, 1); ss += __shfl_xor(ss, 2); ss += __shfl_xor(ss, 4); ss += __shfl_xor(ss, 8);
            const float rstd = rsqrtf(ss * (1.0f / 128.0f) + RMS_EPS);
            const float* gn = a->in[I_MQN] + l * 192 + 64 + 8 * j;
#pragma unroll
            for (int i = 0; i < 8; ++i) x[i] = x[i] * rstd * gn[i];
            if (act) *(u32x4*)ptr = pack8f(x);
        }
        {
            bf16_t* ptr = KV + gg * 256 + 8 * j;
            float x[8]; unpack8(p == 0 ? ld_kn0 : ld_kn1, x);
            float ss = 0.f;
#pragma unroll
            for (int i = 0; i < 8; ++i) ss += x[i] * x[i];
            ss += __shfl_xor(ss, 1); ss += __shfl_xor(ss, 2); ss += __shfl_xor(ss, 4); ss += __shfl_xor(ss, 8);
            const float rstd = rsqrtf(ss * (1.0f / 128.0f) + RMS_EPS);
            const float* gn = a->in[I_MKN] + l * 192 + 64 + 8 * j;
#pragma unroll
            for (int i = 0; i < 8; ++i) x[i] = x[i] * rstd * gn[i];
            if (act) *(u32x4*)ptr = pack8f(x);
        }
    }
}

#define SBAR() __builtin_amdgcn_sched_barrier(0)
__device__ __forceinline__ int v_st(int k, int c) { const int kk = (k & ~0xC) | ((k & 4) << 1) | ((k & 8) >> 1); return ((kk >> 3) * 4 + (c >> 5)) * 512 + ((kk & 7) * 32 + (c & 31)) * 2; }
__device__ __forceinline__ int v_rd_base(int lane) { return ((lane & 3) << 3) | (((lane >> 2) & 3) << 6) | (((lane >> 4) & 1) << 5) | (((lane >> 5) & 1) << 8); }
__device__ __forceinline__ int crow(int r, int hi) { return (r & 3) + 8 * (r >> 2) + 4 * hi; }

template <int KW> __device__ __forceinline__ int kswz(int row) {
    return KW == 128 ? (((row & 7) | (((row >> 4) & 1) << 3)) << 4) : ((((row >> 1) & 1) | (((row >> 2) & 1) << 1) | (((row >> 4) & 1) << 2)) << 4);
}
struct AttnP {
    const bf16_t* Q; int qpitch;
    const bf16_t* K0; int k0pitch;
    const bf16_t* K1; int k1pitch;
    const bf16_t* V; int vpitch;
    const float* cum;
    bf16_t* O;
    int P0, rows;
};

__device__ __forceinline__ void pv_tile(f32x16* o, unsigned vb, bf16x8 pa0, bf16x8 pa1, bf16x8 pa2, bf16x8 pa3) {
#define TRRD(dst, off) asm volatile("ds_read_b64_tr_b16 %0, %1 offset:%2" : "=&v"(dst) : "v"(vb), "i"(off) : "memory")
#define VSET(S, d0) do { constexpr int b_ = (d0) * 512; TRRD(S##l0, b_); TRRD(S##h0, b_ + 2048); TRRD(S##l1, b_ + 4096); TRRD(S##h1, b_ + 6144); \
        TRRD(S##l2, b_ + 8192); TRRD(S##h2, b_ + 10240); TRRD(S##l3, b_ + 12288); TRRD(S##h3, b_ + 14336); } while (0)
#define VMMA(S, d0) do { \
        o[d0] = __builtin_amdgcn_mfma_f32_32x32x16_bf16(pa0, (bf16x8){S##l0[0], S##l0[1], S##l0[2], S##l0[3], S##h0[0], S##h0[1], S##h0[2], S##h0[3]}, o[d0], 0, 0, 0); \
        o[d0] = __builtin_amdgcn_mfma_f32_32x32x16_bf16(pa1, (bf16x8){S##l1[0], S##l1[1], S##l1[2], S##l1[3], S##h1[0], S##h1[1], S##h1[2], S##h1[3]}, o[d0], 0, 0, 0); \
        o[d0] = __builtin_amdgcn_mfma_f32_32x32x16_bf16(pa2, (bf16x8){S##l2[0], S##l2[1], S##l2[2], S##l2[3], S##h2[0], S##h2[1], S##h2[2], S##h2[3]}, o[d0], 0, 0, 0); \
        o[d0] = __builtin_amdgcn_mfma_f32_32x32x16_bf16(pa3, (bf16x8){S##l3[0], S##l3[1], S##l3[2], S##l3[3], S##h3[0], S##h3[1], S##h3[2], S##h3[3]}, o[d0], 0, 0, 0); } while (0)
#define LWAIT(n) do { asm volatile("s_waitcnt lgkmcnt(" #n ")" ::: "memory"); SBAR(); } while (0)
    s16x4 Al0, Al1, Al2, Al3, Ah0, Ah1, Ah2, Ah3, Bl0, Bl1, Bl2, Bl3, Bh0, Bh1, Bh2, Bh3;
    VSET(A, 0);
    VSET(B, 1); LWAIT(8); VMMA(A, 0); SBAR();
    VSET(A, 2); LWAIT(8); VMMA(B, 1); SBAR();
    VSET(B, 3); LWAIT(8); VMMA(A, 2); SBAR();
    LWAIT(0); VMMA(B, 3);
#undef LWAIT
#undef VMMA
#undef VSET
#undef TRRD
}

#ifndef ATT_SPLIT
#define ATT_SPLIT 0
#endif
constexpr int UNIT_ROWS = ATT_SPLIT ? 128 : 256, QB_PER_HEAD = SEQ / UNIT_ROWS, NU_B = 256 + 6 * QB_PER_HEAD;
static_assert(NUNITS == 256 + 12 * QB_PER_HEAD, "unit table");
__device__ __forceinline__ void pv_tile_half(f32x16* o, unsigned vb, bf16x8 pa0, bf16x8 pa1) {
#define TRRD(dst, off) asm volatile("ds_read_b64_tr_b16 %0, %1 offset:%2" : "=&v"(dst) : "v"(vb), "i"(off) : "memory")
#define PV_D0H(d0) do { s16x4 l0, l1, h0, h1; constexpr int b_ = (d0) * 512; \
        TRRD(l0, b_); TRRD(h0, b_ + 2048); TRRD(l1, b_ + 4096); TRRD(h1, b_ + 6144); \
        asm volatile("s_waitcnt lgkmcnt(0)" ::: "memory"); SBAR(); \
        o[d0] = __builtin_amdgcn_mfma_f32_32x32x16_bf16(pa0, (bf16x8){l0[0], l0[1], l0[2], l0[3], h0[0], h0[1], h0[2], h0[3]}, o[d0], 0, 0, 0); \
        o[d0] = __builtin_amdgcn_mfma_f32_32x32x16_bf16(pa1, (bf16x8){l1[0], l1[1], l1[2], l1[3], h1[0], h1[1], h1[2], h1[3]}, o[d0], 0, 0, 0); } while (0)
    PV_D0H(0); PV_D0H(1); PV_D0H(2); PV_D0H(3);
#undef PV_D0H
#undef TRRD
}

#ifndef FORCE_SAFE
#define FORCE_SAFE 0
#endif
template <int MODE, int VARI>
__device__ __forceinline__ void attn_unit(LAS unsigned char* lds, const int tid, const AttnP& a, float c2, float lam, const float* subln, float outscale, float fox_u, const bool fast) {
    constexpr bool SPLIT = (MODE != 0) && (ATT_SPLIT != 0);
    constexpr bool WIDE = (MODE != 0) && !SPLIT;
    constexpr int DK = MODE == 0 ? 64 : (MODE == 1 ? 128 : 192), KW = MODE == 2 ? 192 : 128;
    constexpr int VBYTES = 16384, KBYTES = 64 * KW * 2, OFF_K = 3 * VBYTES, OFF_B = OFF_K + 3 * KBYTES, OFF_W = OFF_B + 8 * 3 * 256;
    constexpr int NDMA = KW / 64 + 2 + (MODE == 1 ? 1 : 0);
    const int wid = __builtin_amdgcn_readfirstlane(tid >> 6), lane = tid & 63, r32 = lane & 31, hi = lane >> 5, grp = wid >> 2;
    const int wrow = (WIDE ? wid : (wid & 3)) * 32, kcoff = MODE == 0 ? grp * 64 : 0, khalf = SPLIT ? grp : 0;
    const int NT = (a.P0 + (WIDE ? 256 : 128)) >> 6;
    const int qpos0 = a.P0 + wrow, pos = qpos0 + r32;
    LAS unsigned char* V_lds = lds; LAS unsigned char* K_lds = lds + OFF_K; LAS float* B_lds = (LAS float*)(lds + OFF_B);
    LAS float* wsc = (LAS float*)(lds + OFF_W) + wid * 64; LAS float* li_l = wsc; LAS float* al_l = wsc + 32;
    bf16x8 qr[DK / 16];
    { const bf16_t* qp = a.Q + (size_t)pos * a.qpitch + kcoff + hi * 8;
#pragma unroll
      for (int d0 = 0; d0 < DK / 16; ++d0) qr[d0] = *(const bf16x8*)(qp + d0 * 16); }
    float cP0 = 0.f, ct2 = 0.f; if (MODE == 1) { cP0 = a.cum[(size_t)a.P0 * 8]; ct2 = a.cum[(size_t)pos * 8] - cP0; }
    float sb = 0.f;
#define A_ISSUE_V(t, bf) do { const int k0_ = (t) * 64; int tt_ = tid; asm volatile("" : "+v"(tt_)); const int ln_ = tt_ & 63; \
        _Pragma("unroll") for (int i_ = 0; i_ < 2; ++i_) { const int ch_ = wid + 8 * i_, b_ = ch_ * 1024 + ln_ * 16, sub_ = b_ >> 9, wi_ = (b_ & 511) >> 1; \
            const int kk_ = (sub_ >> 2) * 8 + (wi_ >> 5), c_ = (sub_ & 3) * 32 + (wi_ & 31), k_ = (kk_ & ~0xC) | ((kk_ & 4) << 1) | ((kk_ & 8) >> 1); \
            __builtin_amdgcn_global_load_lds((const unsigned*)(a.V + (size_t)(k0_ + k_) * a.vpitch + c_), (LAS unsigned*)(V_lds + (bf) * VBYTES + ch_ * 1024), 16, 0, 0); } } while (0)
#define A_ISSUE_K(t, bf) do { const int k0_ = (t) * 64; int tt_ = tid; asm volatile("" : "+v"(tt_)); const int ln_ = tt_ & 63; \
        _Pragma("unroll") for (int i_ = 0; i_ < KW / 64; ++i_) { const int ch_ = wid + 8 * i_, b_ = ch_ * 1024 + ln_ * 16, krow_ = b_ / (KW * 2), cs_ = (b_ % (KW * 2)) >> 4; \
            const int kcc_ = cs_ ^ (kswz<KW>(krow_) >> 4); \
            const bf16_t* p_ = (MODE == 2 && kcc_ >= 8) ? a.K1 + (size_t)(k0_ + krow_) * a.k1pitch + (kcc_ - 8) * 8 : a.K0 + (size_t)(k0_ + krow_) * a.k0pitch + kcc_ * 8; \
            __builtin_amdgcn_global_load_lds((const unsigned*)p_, (LAS unsigned*)(K_lds + (bf) * KBYTES + ch_ * 1024), 16, 0, 0); } } while (0)
    const unsigned krb = (unsigned)(uintptr_t)K_lds + r32 * (KW * 2), kxm = kswz<KW>(r32), kcb = kcoff * 2 + hi * 16;
    const unsigned vb0 = (unsigned)(uintptr_t)V_lds + v_rd_base(lane);

    float m_reg = -1e30f, l_reg = 0.f; f32x16 o[4];
#pragma unroll
    for (int d = 0; d < 4; ++d)
#pragma unroll
        for (int r = 0; r < 16; ++r) o[d][r] = 0.f;

    int t_lo = 0;
    if (MODE == 1) {
        const float thr = 150.f + 2.f * fox_u;
        const int ntq = a.P0 >> 6;
        const int pred = (tid < ntq) && (a.cum[(size_t)(tid * 64 + 63) * 8] - cP0 > thr);
        t_lo = __syncthreads_count(pred);
    }
    if (fast && !FORCE_SAFE) {
      f32x2 ls = {0.f, 0.f};
#define QK_TILE(P0_, P1_, SLOT) do { \
        _Pragma("unroll") for (int r = 0; r < 16; ++r) { P0_[r] = 0.f; P1_[r] = 0.f; } \
        _Pragma("unroll") for (int d0 = 0; d0 < DK / 16; ++d0) { const unsigned ad = krb + ((kcb + 32 * d0) ^ kxm) + (SLOT) * KBYTES + khalf * (32 * KW * 2); \
            P0_ = __builtin_amdgcn_mfma_f32_32x32x16_bf16(*(const LAS bf16x8*)(uintptr_t)ad, qr[d0], P0_, 0, 0, 0); \
            if (!SPLIT) P1_ = __builtin_amdgcn_mfma_f32_32x32x16_bf16(*(const LAS bf16x8*)(uintptr_t)(ad + 32 * KW * 2), qr[d0], P1_, 0, 0, 0); } } while (0)
#define PK4F(P, B_, OUT) do { unsigned a0 = cvtpk(P[B_ + 0], P[B_ + 1]), a1 = cvtpk(P[B_ + 2], P[B_ + 3]); \
        unsigned b0 = cvtpk(P[B_ + 4], P[B_ + 5]), b1 = cvtpk(P[B_ + 6], P[B_ + 7]); \
        auto r0 = __builtin_amdgcn_permlane32_swap(a0, b0, false, false); auto r1 = __builtin_amdgcn_permlane32_swap(a1, b1, false, false); \
        u32x4 w = {r0[0], r1[0], r0[1], r1[1]}; OUT = *reinterpret_cast<bf16x8*>(&w); } while (0)
#define SM_GROUP_ON(P_, J_, KO_, MASKED) do { \
        if (MODE == 1) { const f32x4 cb = *(const LAS f32x4*)(Bw_lds + i0 * 64 + (KO_) + 8 * (J_) + 4 * hi); \
            _Pragma("unroll") for (int e = 0; e < 4; ++e) P_[4 * (J_) + e] = fmaf(P_[4 * (J_) + e], c2, ctp - cb[e]); } \
        else { _Pragma("unroll") for (int e = 0; e < 4; ++e) P_[4 * (J_) + e] *= c2; } \
        if (MASKED) { _Pragma("unroll") for (int e = 0; e < 4; ++e) { if (dq - (e + 8 * (J_) + (KO_)) < 0) P_[4 * (J_) + e] = -__builtin_inff(); } } \
        _Pragma("unroll") for (int e = 0; e < 4; ++e) { P_[4 * (J_) + e] = __builtin_amdgcn_exp2f(P_[4 * (J_) + e]); ls[e & 1] += P_[4 * (J_) + e]; } } while (0)
#define SM_SLICE(S_, MASKED) do { \
        if (MODE == 0) { if ((S_) < 2) { SM_GROUP_ON(pA0, 2 * (S_), 0, MASKED); SM_GROUP_ON(pA0, 2 * (S_) + 1, 0, MASKED); } \
                         else { SM_GROUP_ON(pA1, 2 * (S_) - 4, 32, MASKED); SM_GROUP_ON(pA1, 2 * (S_) - 3, 32, MASKED); } \
                         if ((S_) == 0) PK4F(pA0, 0, pa0); else if ((S_) == 1) PK4F(pA0, 8, pa1); else if ((S_) == 2) PK4F(pA1, 0, pa2); else PK4F(pA1, 8, pa3); } \
        else if (WIDE) { if ((S_) < 4) SM_GROUP_ON(pA0, (S_), 0, MASKED); else if ((S_) < 8) SM_GROUP_ON(pA1, (S_) - 4, 32, MASKED); \
                         if ((S_) == 1) PK4F(pA0, 0, pa0); else if ((S_) == 3) PK4F(pA0, 8, pa1); else if ((S_) == 5) PK4F(pA1, 0, pa2); else if ((S_) == 7) PK4F(pA1, 8, pa3); } \
        else if (MODE == 1) { if ((S_) < 4) SM_GROUP_ON(pA0, (S_), 32 * khalf, MASKED); else if ((S_) == 5) PK4F(pA0, 0, pa0); else if ((S_) == 6) PK4F(pA0, 8, pa1); } \
        else { if ((S_) < 8 && !((S_) & 1)) SM_GROUP_ON(pA0, (S_) >> 1, 32 * khalf, MASKED); else if ((S_) == 8) PK4F(pA0, 0, pa0); else if ((S_) == 9) PK4F(pA0, 8, pa1); } } while (0)
#define FAST_TILE(MASKED) do { f32x16 pB0, pB1; bf16x8 pa0, pa1, pa2, pa3; \
        _Pragma("unroll") for (int r = 0; r < 16; ++r) { pB0[r] = 0.f; pB1[r] = 0.f; } \
        _Pragma("unroll") for (int s = 0; s < DK / 16; ++s) { bf16x8 kfa, kfb; SBAR(); \
            { const unsigned ad = krb + ((kcb + 32 * s) ^ kxm) + i1 * KBYTES + khalf * (32 * KW * 2);     \
              kfa = *(const LAS bf16x8*)(uintptr_t)ad; if (!SPLIT) kfb = *(const LAS bf16x8*)(uintptr_t)(ad + 32 * KW * 2); } \
            SM_SLICE(s, MASKED); \
            pB0 = __builtin_amdgcn_mfma_f32_32x32x16_bf16(kfa, qr[s], pB0, 0, 0, 0);     \
            if (!SPLIT) pB1 = __builtin_amdgcn_mfma_f32_32x32x16_bf16(kfb, qr[s], pB1, 0, 0, 0); } \
        SBAR(); \
        if (SPLIT) pv_tile_half(o, vb0 + i0 * VBYTES + khalf * 8192, pa0, pa1); else pv_tile(o, vb0 + i0 * VBYTES, pa0, pa1, pa2, pa3); \
        pA0 = pB0; if (!SPLIT) pA1 = pB1; } while (0)
      unsigned voff[2], koff[KW / 64], kstp[KW / 64], boff = 0; int vt = t_lo, kt = t_lo;
      { int tt_ = tid; asm volatile("" : "+v"(tt_)); const int ln_ = tt_ & 63;
#pragma unroll
        for (int i_ = 0; i_ < 2; ++i_) { const int ch_ = wid + 8 * i_, b_ = ch_ * 1024 + ln_ * 16, sub_ = b_ >> 9, wi_ = (b_ & 511) >> 1;
            const int kk_ = (sub_ >> 2) * 8 + (wi_ >> 5), c_ = (sub_ & 3) * 32 + (wi_ & 31), k_ = (kk_ & ~0xC) | ((kk_ & 4) << 1) | ((kk_ & 8) >> 1);
            voff[i_] = (unsigned)(((t_lo * 64 + k_) * a.vpitch + c_) * 2); }
#pragma unroll
        for (int i_ = 0; i_ < KW / 64; ++i_) { const int ch_ = wid + 8 * i_, b_ = ch_ * 1024 + ln_ * 16, krow_ = b_ / (KW * 2), cs_ = (b_ % (KW * 2)) >> 4;
            const int kcc_ = cs_ ^ (kswz<KW>(krow_) >> 4);
            if (MODE == 2 && kcc_ >= 8) { koff[i_] = (unsigned)((const char*)a.K1 - (const char*)a.K0) + (unsigned)(((t_lo * 64 + krow_) * a.k1pitch + (kcc_ - 8) * 8) * 2); kstp[i_] = (unsigned)(64 * a.k1pitch * 2); }
            else { koff[i_] = (unsigned)(((t_lo * 64 + krow_) * a.k0pitch + kcc_ * 8) * 2); kstp[i_] = (unsigned)(64 * a.k0pitch * 2); } }
        if (MODE == 1) boff = (unsigned)((t_lo * 64 + ln_) * 32); }
#define DMA_V(T_, SLOT) do { \
        _Pragma("unroll") for (int i_ = 0; i_ < 2; ++i_) \
            __builtin_amdgcn_global_load_lds((const unsigned*)((const char*)a.V + voff[i_]), (LAS unsigned*)(V_lds + (SLOT) * VBYTES + (wid + 8 * i_) * 1024), 16, 0, 0); \
        if (MODE == 1) __builtin_amdgcn_global_load_lds((const unsigned*)((const char*)a.cum + boff), (LAS unsigned*)(Bw_lds + (SLOT) * 64), 4, 0, 0); \
        if (vt < NT - 1) { ++vt; _Pragma("unroll") for (int i_ = 0; i_ < 2; ++i_) voff[i_] += (unsigned)(64 * a.vpitch * 2); if (MODE == 1) boff += 64 * 32; } } while (0)
#define DMA_K(T_, SLOT) do { \
        _Pragma("unroll") for (int i_ = 0; i_ < KW / 64; ++i_) \
            __builtin_amdgcn_global_load_lds((const unsigned*)((const char*)a.K0 + koff[i_]), (LAS unsigned*)(K_lds + (SLOT) * KBYTES + (wid + 8 * i_) * 1024), 16, 0, 0); \
        if (kt < NT - 1) { ++kt; _Pragma("unroll") for (int i_ = 0; i_ < KW / 64; ++i_) koff[i_] += kstp[i_]; } } while (0)
      LAS float* Bw_lds = B_lds + wid * 192;
      const float ctp = ct2 + cP0;
      int i0 = t_lo % 3, i1 = (t_lo + 1) % 3, i2 = (t_lo + 2) % 3;
      DMA_K(t_lo, i0); DMA_V(t_lo, i0); DMA_K(t_lo + 1, i1); DMA_V(t_lo + 1, i1); DMA_K(t_lo + 2, i2);
      asm volatile("s_waitcnt vmcnt(0)" ::: "memory"); __builtin_amdgcn_s_barrier(); asm volatile("" ::: "memory");
      f32x16 pA0, pA1;
      QK_TILE(pA0, pA1, i0);
      asm volatile("s_waitcnt lgkmcnt(0)" ::: "memory"); __builtin_amdgcn_s_barrier(); asm volatile("" ::: "memory");
      const int t_nm = a.P0 >> 6;
#define FAST_ITER(MASKED) do { \
        if (!(VARI & 16)) { DMA_K(t + 3, i0);         \
        DMA_V(t + 2, i2); }                           \
        const int dq = pos - t * 64 - 4 * hi; (void)dq; \
        FAST_TILE(MASKED); \
        if (!(VARI & 8)) { asm volatile("s_waitcnt vmcnt(%0)" :: "n"(NDMA) : "memory");     \
        __builtin_amdgcn_s_barrier(); } asm volatile("" ::: "memory"); \
        { const int r_ = i0; i0 = i1; i1 = i2; i2 = r_; } } while (0)
      int t = t_lo;
      for (; t < t_nm; ++t) FAST_ITER(false);
      for (; t < NT; ++t) FAST_ITER(true);
#undef FAST_ITER
#undef DMA_K
#undef DMA_V
#undef FAST_TILE
#undef SM_SLICE
#undef SM_GROUP_ON
#undef PK4F
#undef QK_TILE
      { float ps = ls[0] + ls[1];
        auto rr = __builtin_amdgcn_permlane32_swap(__float_as_uint(ps), __float_as_uint(ps), false, false);
        l_reg = __uint_as_float(rr[0]) + __uint_as_float(rr[1]); }
    } else {
    int tl_ = lane; asm volatile("" : "+v"(tl_));
    const int r32_s = tl_ & 31, hi_s = tl_ >> 5, pos_s = qpos0 + r32_s;
    const unsigned krb_s = (unsigned)(uintptr_t)K_lds + r32_s * (KW * 2), kxm_s = kswz<KW>(r32_s), kcb_s = kcoff * 2 + hi_s * 16;
    const unsigned vb0_s = (unsigned)(uintptr_t)V_lds + v_rd_base(tl_);
    const bool active = !SPLIT || wid < 4;
#define S_ISSUE(t, bf) do { A_ISSUE_V(t, bf); A_ISSUE_K(t, bf); if (MODE == 1) { int tt_ = tid; asm volatile("" : "+v"(tt_)); if (tt_ < 64) sb = cP0 - a.cum[(size_t)((t) * 64 + tt_) * 8]; } } while (0)
#define S_WRITE(bf) do { if (MODE == 1) { int tt_ = tid; asm volatile("" : "+v"(tt_)); if (tt_ < 64) B_lds[(bf) * 64 + tt_] = sb; } } while (0)
    S_ISSUE(t_lo, t_lo & 1); S_WRITE(t_lo & 1);
    __syncthreads();
    for (int t = t_lo; t < NT; ++t) {
        const int bf = t & 1;
        if (t + 1 < NT) S_ISSUE(t + 1, bf ^ 1);
        if (active) {
        f32x16 p0, p1;
#pragma unroll
        for (int r = 0; r < 16; ++r) { p0[r] = 0.f; p1[r] = 0.f; }
#pragma unroll
        for (int d0 = 0; d0 < DK / 16; ++d0) {
            const unsigned ad = krb_s + ((kcb_s + 32 * d0) ^ kxm_s) + bf * KBYTES;
            const bf16x8 b0 = *(const LAS bf16x8*)(uintptr_t)ad;
            const bf16x8 b1 = *(const LAS bf16x8*)(uintptr_t)(ad + 32 * KW * 2);
            p0 = __builtin_amdgcn_mfma_f32_32x32x16_bf16(b0, qr[d0], p0, 0, 0, 0);
            p1 = __builtin_amdgcn_mfma_f32_32x32x16_bf16(b1, qr[d0], p1, 0, 0, 0);
            if ((d0 & 3) == 3) SBAR();
        }
        if (MODE == 1) {
#pragma unroll
            for (int j = 0; j < 4; ++j) {
                const f32x4 c0 = *(const LAS f32x4*)(B_lds + bf * 64 + 8 * j + 4 * hi_s), c1 = *(const LAS f32x4*)(B_lds + bf * 64 + 32 + 8 * j + 4 * hi_s);
#pragma unroll
                for (int e = 0; e < 4; ++e) { p0[4 * j + e] = fmaf(p0[4 * j + e], c2, ct2 + c0[e]); p1[4 * j + e] = fmaf(p1[4 * j + e], c2, ct2 + c1[e]); }
            }
        } else {
#pragma unroll
            for (int r = 0; r < 16; ++r) { p0[r] *= c2; p1[r] *= c2; }
        }
        if (t * 64 + 63 > qpos0) {
            const int dq = pos_s - t * 64 - 4 * hi_s; const float NEG = -__builtin_inff();
#pragma unroll
            for (int r = 0; r < 16; ++r) { const int cc = (r & 3) + 8 * (r >> 2); if (dq - cc < 0) p0[r] = NEG; if (dq - cc - 32 < 0) p1[r] = NEG; }
        }
        float pmax = p0[0];
#pragma unroll
        for (int r = 1; r < 16; ++r) pmax = fmaxf(pmax, p0[r]);
#pragma unroll
        for (int r = 0; r < 16; ++r) pmax = fmaxf(pmax, p1[r]);
        { auto rr = __builtin_amdgcn_permlane32_swap(__float_as_uint(pmax), __float_as_uint(pmax), false, false);
          pmax = fmaxf(__uint_as_float(rr[0]), __uint_as_float(rr[1])); }
        float mn, alpha;
        if (__all(pmax - m_reg <= 8.0f)) { mn = m_reg; alpha = 1.f; }
        else { mn = fmaxf(m_reg, pmax); alpha = __builtin_amdgcn_exp2f(m_reg - mn); m_reg = mn; }
        float ps = 0.f;
#pragma unroll
        for (int r = 0; r < 16; ++r) { p0[r] = __builtin_amdgcn_exp2f(p0[r] - mn); p1[r] = __builtin_amdgcn_exp2f(p1[r] - mn); }
#pragma unroll
        for (int r = 0; r < 16; ++r) ps += p0[r] + p1[r];
        { auto rr = __builtin_amdgcn_permlane32_swap(__float_as_uint(ps), __float_as_uint(ps), false, false);
          ps = __uint_as_float(rr[0]) + __uint_as_float(rr[1]); }
        l_reg = l_reg * alpha + ps;
        bf16x8 pa0, pa1, pa2, pa3;
#define PK4(P, B_, OUT) do { unsigned a0 = cvtpk(P[B_ + 0], P[B_ + 1]), a1 = cvtpk(P[B_ + 2], P[B_ + 3]); \
        unsigned b0 = cvtpk(P[B_ + 4], P[B_ + 5]), b1 = cvtpk(P[B_ + 6], P[B_ + 7]); \
        auto r0 = __builtin_amdgcn_permlane32_swap(a0, b0, false, false); auto r1 = __builtin_amdgcn_permlane32_swap(a1, b1, false, false); \
        u32x4 w = {r0[0], r1[0], r0[1], r1[1]}; OUT = *reinterpret_cast<bf16x8*>(&w); } while (0)
        PK4(p0, 0, pa0); PK4(p0, 8, pa1); PK4(p1, 0, pa2); PK4(p1, 8, pa3);
#undef PK4
        if (__any(alpha < 1.f)) {
            if (hi_s == 0) al_l[r32_s] = alpha;
            asm volatile("s_waitcnt lgkmcnt(0)" ::: "memory");
#pragma unroll
            for (int r = 0; r < 16; ++r) { const float al = al_l[crow(r, hi_s)];
#pragma unroll
                for (int d = 0; d < 4; ++d) o[d][r] *= al; }
        }
        pv_tile(o, vb0_s + bf * VBYTES, pa0, pa1, pa2, pa3);
        }
        if (t + 1 < NT) S_WRITE(bf ^ 1);
        __syncthreads();
    }
#undef S_ISSUE
#undef S_WRITE
    }
#undef A_ISSUE_V
#undef A_ISSUE_K
    asm volatile("s_waitcnt vmcnt(0)" ::: "memory");
    __syncthreads();
    LAS float* X = (LAS float*)lds + (wid & 3) * 4096 + lane;
    LAS float* LX = (LAS float*)(lds + 65536) + (wid & 3) * 32;
    if (MODE == 0) {
        if (hi == 0) li_l[r32] = l_reg;
        asm volatile("s_waitcnt lgkmcnt(0)" ::: "memory");
#pragma unroll
        for (int r = 0; r < 16; ++r) { const float rl = __builtin_amdgcn_rcpf(li_l[crow(r, hi)]);
#pragma unroll
            for (int d = 0; d < 4; ++d) o[d][r] *= rl; }
        if (wid >= 4) {
#pragma unroll
            for (int d = 0; d < 4; ++d)
#pragma unroll
                for (int r = 0; r < 16; ++r) X[(d * 16 + r) * 64] = o[d][r];
        }
        __syncthreads();
        if (wid < 4) {
            const float g0 = subln[r32], g1 = subln[32 + r32], g2 = subln[64 + r32], g3 = subln[96 + r32];
#pragma unroll
            for (int r = 0; r < 16; ++r) {
                float v[4]; float ss = 0.f;
#pragma unroll
                for (int d = 0; d < 4; ++d) { v[d] = o[d][r] - lam * X[(d * 16 + r) * 64]; ss += v[d] * v[d]; }
                ss += __shfl_xor(ss, 1); ss += __shfl_xor(ss, 2); ss += __shfl_xor(ss, 4); ss += __shfl_xor(ss, 8); ss += __shfl_xor(ss, 16);
                const float rs = rsqrtf(ss * (1.0f / 128.0f) + RMS_EPS) * outscale;
                o[0][r] = v[0] * rs * g0; o[1][r] = v[1] * rs * g1; o[2][r] = v[2] * rs * g2; o[3][r] = v[3] * rs * g3;
            }
        }
    } else if (WIDE) {
        if (hi == 0) li_l[r32] = l_reg;
        asm volatile("s_waitcnt lgkmcnt(0)" ::: "memory");
#pragma unroll
        for (int r = 0; r < 16; ++r) { const float rl = __builtin_amdgcn_rcpf(li_l[crow(r, hi)]);
#pragma unroll
            for (int d = 0; d < 4; ++d) o[d][r] *= rl; }
    } else {
        if (wid >= 4) {
#pragma unroll
            for (int d = 0; d < 4; ++d)
#pragma unroll
                for (int r = 0; r < 16; ++r) X[(d * 16 + r) * 64] = o[d][r];
            if (hi == 0) LX[r32] = l_reg;
        }
        __syncthreads();
        if (wid < 4) {
            if (hi == 0) li_l[r32] = l_reg + LX[r32];
            asm volatile("s_waitcnt lgkmcnt(0)" ::: "memory");
#pragma unroll
            for (int r = 0; r < 16; ++r) { const float rl = __builtin_amdgcn_rcpf(li_l[crow(r, hi)]);
#pragma unroll
                for (int d = 0; d < 4; ++d) o[d][r] = (o[d][r] + X[(d * 16 + r) * 64]) * rl; }
        }
    }
    if (WIDE || wid < 4) {
        bf16_t* Ow = a.O + (size_t)qpos0 * 2048;
#pragma unroll
        for (int r = 0; r < 16; ++r) { const int orow = crow(r, hi);
#pragma unroll
            for (int d = 0; d < 4; ++d) { const float v = o[d][r]; const float vn = __shfl_xor(v, 1);
                if ((r32 & 1) == 0) *(unsigned*)(Ow + (size_t)orow * 2048 + d * 32 + r32) = cvtpk(v, vn); } }
    }
    __syncthreads();
}

#ifndef DUP
#define DUP 0
#endif
#ifndef AV
#define AV 0
#endif
__device__ __forceinline__ void tr_drain(ArgsP a, LAS unsigned char* lds, int tid, int* counter, int l, int late, int max_chunks) {
    LAS int* slot = (LAS int*)(lds + LDS_BYTES - 64);
    const int lane = tid & 63, wave = __builtin_amdgcn_readfirstlane(tid >> 6), n_items = late ? TR_N_LATE : TR_N_EARLY, n_chunks = (n_items + TR_CHUNK - 1) / TR_CHUNK;
    LAS float* scr = (LAS float*)(lds + wave * 8704);
    for (int n = 0; n < max_chunks; ++n) {
        if (tid == 0) *slot = atomicAdd(counter, 1);
        __syncthreads();
        const int ch = *slot;
        __syncthreads();
        if (ch >= n_chunks) break;
#pragma unroll 1
        for (int j = 0; j < 4; ++j) { const int i = ch * TR_CHUNK + wave * 4 + j; if (i < n_items) tr_dispatch(a, l, late ? tr_late_item(i) : tr_early_item(i), scr, lane); }
    }
}
template <int VARI>
__device__ __forceinline__ void attention_phase(ArgsP a, int l, LAS unsigned char* lds, int cslot) {
    unsigned char* ws = a->ws;
    const bf16_t* PROJ = (const bf16_t*)(ws + WS_PROJ); const bf16_t* QC = (const bf16_t*)(ws + WS_QC); const bf16_t* KVC = (const bf16_t*)(ws + WS_KVC);
    bf16_t* MIX = (bf16_t*)(ws + (VARI == 0 ? WS_MIX : WS_END));
    const int* table = (const int*)(ws + WS_TABLE); int* counter = (int*)(ws + WS_CNT) + 4 * (l + cslot);
    LAS int* slot = (LAS int*)(lds + LDS_BYTES - 64);
    const float lam = ((const float*)(ws + WS_LAM))[l], fox_u = ((const float*)(ws + WS_LAM))[8 + l], ub_a = ((const float*)(ws + WS_LAM))[12 + l], ub_c = ((const float*)(ws + WS_LAM))[16 + l];
    const float linit = 0.8f - 0.6f * expf(-0.3f * (float)l);
    int tid_ = threadIdx.x; asm volatile("" : "+v"(tid_)); const int tid = tid_;
    for (;;) {
        if (tid == 0) *slot = atomicAdd(counter, 1);
        __syncthreads();
        const int idx = *slot;
        __syncthreads();
        if (idx >= NUNITS) break;
        const int id = table[idx];
        int tu_ = tid; asm volatile("" : "+v"(tu_)); const int tu = tu_;
        AttnP p{};
#ifndef ATM
#define ATM 7
#endif
        if (id < 256 && (ATM & 1) && (VARI == 0 || (VARI & 1))) {
            const int h = id >> 6, qb = id & 63;
            p.Q = PROJ + C_DQ + h * 128; p.qpitch = NINP; p.K0 = PROJ + C_DK + h * 128; p.k0pitch = NINP; p.K1 = p.K0; p.k1pitch = NINP;
            p.V = PROJ + C_DV + h * 128; p.vpitch = NINP; p.cum = nullptr; p.O = MIX + h * 128; p.P0 = qb * 128; p.rows = 128;
            attn_unit<0, VARI>(lds, tu, p, 0.125f * LOG2E, lam, a->in[I_SUBLN] + l * 128, 1.0f - linit, 0.f, ub_a < 60.f);
        } else if (id >= 256 && id < NU_B && (ATM & 2) && (VARI == 0 || (VARI & 2))) {
            const int h = (id - 256) / QB_PER_HEAD, qb = (id - 256) % QB_PER_HEAD;
            p.Q = PROJ + C_FQ + h * 128; p.qpitch = NINP; p.K0 = PROJ + C_FK + h * 128; p.k0pitch = NINP; p.K1 = p.K0; p.k1pitch = NINP;
            p.V = PROJ + C_FV + h * 128; p.vpitch = NINP; p.cum = (const float*)(ws + WS_CUM) + h; p.O = MIX + 512 + h * 128; p.P0 = qb * UNIT_ROWS; p.rows = UNIT_ROWS;
            attn_unit<1, VARI>(lds, tu, p, 0.08838834764831845f * LOG2E, 0.f, nullptr, 1.f, fox_u, fox_u < 60.f);
        } else if (id >= NU_B && (ATM & 4) && (VARI == 0 || (VARI & 4))) {
            const int h = (id - NU_B) / QB_PER_HEAD, qb = (id - NU_B) % QB_PER_HEAD;
            p.Q = QC + h * 192; p.qpitch = NQUPP; p.K0 = PROJ + C_KR; p.k0pitch = NINP; p.K1 = KVC + h * 256; p.k1pitch = NKVUP;
            p.V = KVC + h * 256 + 128; p.vpitch = NKVUP; p.cum = nullptr; p.O = MIX + 1280 + h * 128; p.P0 = qb * UNIT_ROWS; p.rows = UNIT_ROWS;
            attn_unit<2, VARI>(lds, tu, p, 0.07216878364870322f * LOG2E, 0.f, nullptr, 1.f, 0.f, ub_c < 60.f);
        }
    }    if (VARI == 0) {
        int* cnt = (int*)(ws + WS_CNT);
        tr_drain(a, lds, tid, cnt + 24 + 2 * l, l, 1, 1 << 20);
        if (l == 0) tr_drain(a, lds, tid, cnt + 25, 1, 0, 1 << 20);
    }
}

#ifndef PHM
#define PHM 0x1ff
#endif
constexpr int PH_PER_LAYER = 8, N_PHASES = 1 + 2 * PH_PER_LAYER;
__global__ void __launch_bounds__(512, 2) fwd_kernel(Args a_unused) {
    extern __shared__ __attribute__((aligned(16))) unsigned char lds_raw[];
    LAS unsigned char* lds = (LAS unsigned char*)lds_raw;
    cg::grid_group grid = cg::this_grid();
    ArgsP a0 = (ArgsP)__builtin_amdgcn_kernarg_segment_ptr();
    const int G = gridDim.x, ph_lo = a0->ph_lo, ph_hi = a0->ph_hi;
    volatile LAS unsigned* bst = (volatile LAS unsigned*)(lds + 131072 + 128);
    if (threadIdx.x == 0) { bst[0] = 0u; bst[1] = 0u; }
    __syncthreads();
    (void)xcd_barrier_post((unsigned*)(a0->ws + WS_BAR), bst);
    int ph = ph_lo;
    if (ph_hi > 1000) grid.sync();
    if (ph == 0) {
        ArgsP ap = a0; asm volatile("" : "+s"(ap)); if (PHM & 1) prologue(ap, lds);
        ph = 1;
        if (ph < ph_hi) { XcdBarrier b2; b2.bar = (unsigned*)(ap->ws + WS_BAR); b2.x = xb_xcc_id(); b2.st = bst; xcd_barrier(b2); }
    }
    for (; ph < ph_hi; ++ph) {
        ArgsP a = a0; asm volatile("" : "+s"(a));
        unsigned char* ws = a->ws;
        bf16_t* XB = (bf16_t*)(ws + WS_XB); float* XF = (float*)(ws + WS_XF); bf16_t* MIX = (bf16_t*)(ws + WS_MIX); bf16_t* PROJ = (bf16_t*)(ws + WS_PROJ);
        bf16_t* QC = (bf16_t*)(ws + WS_QC); bf16_t* KVC = (bf16_t*)(ws + WS_KVC); bf16_t* HB = (bf16_t*)(ws + WS_H); float* SSQ = (float*)(ws + WS_SSQ);
                const int l = (ph - 1) / PH_PER_LAYER, sp = (ph - 1) % PH_PER_LAYER;
        int tid_ = threadIdx.x; asm volatile("" : "+v"(tid_));
        const int lane = tid_ & 63, wave = __builtin_amdgcn_readfirstlane(tid_ >> 6), gw = blockIdx.x * 8 + wave, NGW = G * 8;
        if (sp == 0 && (PHM & 2)) {
            pg8::Gemm g{XB, (const bf16_t*)(ws + WS_WIN + l * SZ_WIN), SEQ, NINP, DM, DM}; pg8::StaticOrder S; S.init(SEQ, NINP, G, (int)blockIdx.x);
            pg8::EpiScaleBf16<false> E{PROJ, NINP, SSQ + (2 * l) * SEQ};
            pg8::gemm_phase<pg8::EpiScaleBf16<false>, pg8::StaticOrder, true, true>(lds, g, S, E);
            if ((int)blockIdx.x >= (SEQ / 256) * (NINP / 256) - 2 * G) tr_drain(a, lds, tid_, (int*)(ws + WS_CNT) + 24 + 2 * l, l, 1, 1);
        } else if (sp == 1 && (PHM & 4)) {
            for (int m = gw; m < SEQ; m += NGW) post_proj_row(a, l, m, lane);
        } else if (sp == 2 && (PHM & 8)) {
            if (blockIdx.x < 6) fox_cumsum(a, blockIdx.x, lds);
            { pg8::Gemm g{PROJ + C_MQ, (const bf16_t*)(ws + WS_WQUP + l * SZ_WQUP), SEQ, NQUPP, 512, NINP}; pg8::StaticOrder S; S.init(SEQ, NQUPP, G, (int)blockIdx.x);
              pg8::EpiScaleBf16<false> E{QC, NQUPP, nullptr};
              pg8::gemm_phase<pg8::EpiScaleBf16<false>, pg8::StaticOrder, true, true>(lds, g, S, E); }
            { pg8::Gemm g{PROJ + C_CKV, (const bf16_t*)(ws + WS_WKVUP + l * SZ_WKVUP), SEQ, NKVUP, 256, NINP}; pg8::StaticOrder S; S.init(SEQ, NKVUP, G, (int)((blockIdx.x + 128) % G));
              pg8::EpiScaleBf16<false> E{KVC, NKVUP, nullptr};
              pg8::gemm_phase<pg8::EpiScaleBf16<false>, pg8::StaticOrder, true, true>(lds, g, S, E); }
        } else if (sp == 3 && (PHM & 16)) {
            for (int m = gw; m < SEQ; m += NGW) post_mla_row(a, l, m, lane);
        } else if (sp == 4 && (PHM & 32)) {
            attention_phase<0>(a, l, lds, 0);
#if DUP & 1
            { XcdBarrier b2; b2.bar = (unsigned*)(a->ws + WS_BAR); b2.x = xb_xcc_id(); b2.st = bst; xcd_barrier(b2); } attention_phase<AV>(a, l, lds, 2);
#endif
        } else if (sp == 5 && (PHM & 64)) {
            pg8::Gemm g{MIX, (const bf16_t*)(ws + WS_WOUT + l * SZ_WOUT), SEQ, DM, DM, DM}; pg8::StaticOrder S; S.init(SEQ, DM, G, (int)blockIdx.x);
            pg8::EpiResid E{l == 0 ? a->in[I_X] : (const float*)XF, XF, XB, SSQ + (2 * l + 1) * SEQ};
            pg8::gemm_phase<pg8::EpiResid, pg8::StaticOrder, true, true>(lds, g, S, E);
        } else if (sp == 6 && (PHM & 128)) {
            pg8::Gemm g{XB, (const bf16_t*)(ws + WS_WUP + l * SZ_WUP), SEQ, DFF, DM, DM}; pg8::StaticOrder S; S.init(SEQ, DFF, G, (int)blockIdx.x);
            pg8::EpiScaleBf16<true> E{HB, DFF, SSQ + (2 * l + 1) * SEQ};
            pg8::gemm_phase<pg8::EpiScaleBf16<true>, pg8::StaticOrder, true, true>(lds, g, S, E);
#if DUP & 4
            { XcdBarrier b2; b2.bar = (unsigned*)(a->ws + WS_BAR); b2.x = xb_xcc_id(); b2.st = bst; xcd_barrier(b2); } pg8::gemm_phase<pg8::EpiScaleBf16<true>, pg8::StaticOrder, true, true>(lds, g, S, E);
#endif
        } else if (sp == 7 && (PHM & 256)) {
            pg8::Gemm g{HB, (const bf16_t*)(ws + WS_WDN + l * SZ_WDN), SEQ, DM, DFF, DFF}; pg8::StaticOrder S; S.init(SEQ, DM, G, (int)blockIdx.x);
            pg8::EpiResid E{XF, l == 1 ? a->out : XF, l == 1 ? nullptr : XB, l == 1 ? nullptr : SSQ + 2 * SEQ};
            pg8::gemm_phase<pg8::EpiResid, pg8::StaticOrder, true, true>(lds, g, S, E);
        }
        if (ph + 1 < ph_hi) { XcdBarrier b2; b2.bar = (unsigned*)(a->ws + WS_BAR); b2.x = xb_xcc_id(); b2.st = bst; xcd_barrier(b2); }
    }
}

#ifndef ONE_LAUNCH
#define ONE_LAUNCH 1
#endif
extern "C" void kernel_launch(void* const* d_in, const int* in_sizes, int n_in, void* d_out, int out_size, void* d_ws, size_t ws_size, hipStream_t stream) {
    static int grid = 0;
    if (grid == 0) {
        if (n_in != 23 || out_size != SEQ * DM || ws_size < WS_END + 32 * MiB) { fprintf(stderr, "kernel_launch: unexpected shapes (n_in %d out %d ws %zu)\n", n_in, out_size, ws_size); grid = -1; return; }
        int dev = 0, cus = 0, per_cu = 0;
        (void)hipGetDevice(&dev); (void)hipDeviceGetAttribute(&cus, hipDeviceAttributeMultiprocessorCount, dev);
        if (hipFuncSetAttribute((const void*)fwd_kernel, hipFuncAttributeMaxDynamicSharedMemorySize, LDS_BYTES) != hipSuccess) { fprintf(stderr, "kernel_launch: hipFuncSetAttribute failed\n"); grid = -1; return; }
        if (hipOccupancyMaxActiveBlocksPerMultiprocessor(&per_cu, (const void*)fwd_kernel, 512, LDS_BYTES) != hipSuccess || per_cu < 1) { fprintf(stderr, "kernel_launch: occupancy query says %d\n", per_cu); per_cu = 1; }
        (void)hipGetLastError();
        if (cus <= 0) cus = 256;
        grid = cus;
    }
    if (grid < 0) return;
    if (hipMemsetAsync((char*)d_ws + WS_BAR, 0, XCD_BAR_WORDS * 4, stream) != hipSuccess) { fprintf(stderr, "kernel_launch: hipMemsetAsync failed\n"); return; }
    Args a{};
    for (int i = 0; i < 23; ++i) a.in[i] = (const float*)d_in[i];
    a.out = (float*)d_out; a.ws = (unsigned char*)d_ws;
#if ONE_LAUNCH
    a.ph_lo = 0; a.ph_hi = N_PHASES;
    { void* args[] = {&a};
      hipError_t e = hipLaunchCooperativeKernel((const void*)fwd_kernel, dim3(grid), dim3(512), args, LDS_BYTES, stream);
      if (e != hipSuccess) fprintf(stderr, "cooperative launch failed: %s (grid %d)\n", hipGetErrorString(e), grid); }
#else
    for (int ph = 0; ph < N_PHASES; ++ph) {
        a.ph_lo = ph; a.ph_hi = ph + 1;
        void* args[] = {&a};
        hipError_t e = hipLaunchCooperativeKernel((const void*)fwd_kernel, dim3(grid), dim3(512), args, LDS_BYTES, stream);
        if (e != hipSuccess) { fprintf(stderr, "cooperative launch %d failed: %s (grid %d)\n", ph, hipGetErrorString(e), grid); break; }
    }
#endif
}
```

```cpp
#include <hip/hip_runtime.h>
#include <hip/hip_cooperative_groups.h>
#include <cstdio>
#include <cstdint>
namespace cg = cooperative_groups;
constexpr float RMS_EPS = 1e-6f;
namespace pg8 {
#define PG8_LAS __attribute__((address_space(3)))
typedef unsigned short bf16_t;
typedef short bf16x8 __attribute__((ext_vector_type(8)));
typedef float f32x4 __attribute__((ext_vector_type(4)));
typedef unsigned u32x4 __attribute__((ext_vector_type(4)));
constexpr int BM = 256, BK = 64, HALF = 128, HTB = HALF * BK * 2  , STAGE_BYTES = 8 * HTB, NXCD = 8, WGM = 2;

__host__ __device__ __forceinline__ int lds_byte(int r, int c) { const int st = (r >> 4) * 2 + (c >> 5), rr = r & 15, cc = c & 31, ob = rr * 64 + cc * 2; return st * 1024 + (ob ^ (((ob >> 9) & 1) << 5)); }
__host__ __device__ __forceinline__ void stage_rc(int b, int& R, int& C) { const int st = b / 1024, sb = b % 1024, swz = sb ^ (((sb >> 9) & 1) << 5); R = (st >> 1) * 16 + swz / 64; C = (st & 1) * 32 + (swz % 64) / 2; }
__host__ __device__ __forceinline__ int perm32(int rho) { const int n = rho >> 4, i = rho & 15; return 8 * (i >> 2) + 4 * n + (i & 3); }

struct Unit { int pm, pn; };
struct Gemm { const bf16_t* A; const bf16_t* Bt; int M, N, K, lda; };

struct StaticOrder {
    int nM, nN, nwg, G, c;
    __host__ __device__ void init(int M, int N, int G_, int c_) { nM = M / BM; nN = N / BM; nwg = nM * nN; G = G_; c = c_; }
    __host__ __device__ bool next(int i, Unit& u) const {
        const long L = (long)i * G + c; if (L >= nwg) return false;
        int wgid = (int)L; { const int q = nwg / NXCD, r = nwg % NXCD, xcd = wgid % NXCD, off = wgid / NXCD; wgid = (xcd < r ? xcd * (q + 1) : r * (q + 1) + (xcd - r) * q) + off; }
        const int nig = WGM * nN, gid = wgid / nig, fm = gid * WGM, gsz = (nM - fm) < WGM ? (nM - fm) : WGM;
        u.pm = fm + ((wgid % nig) % gsz); u.pn = (wgid % nig) / gsz; return true;
    }
    __device__ __forceinline__ void a_ready(const Unit&) const {}
    __device__ __forceinline__ void done(const Unit&) const {}
};

typedef float cvt2_f32x2 __attribute__((ext_vector_type(2))); typedef __bf16 cvt2_bf16x2 __attribute__((ext_vector_type(2)));
__device__ __forceinline__ unsigned cvt_pk_bf16(float lo, float hi) { const cvt2_f32x2 v = {lo, hi}; const cvt2_bf16x2 r = __builtin_convertvector(v, cvt2_bf16x2); return __builtin_bit_cast(unsigned, r); }


template <bool RELU2> struct EpiScaleBf16 {
    static constexpr bool PERM = true, AFTER_DRAIN = false;
    bf16_t* O; int ldc; const float* ssq;
    __device__ __forceinline__ void operator()(const f32x4 (&acc)[2][2][4][2], const Unit& u, int wr, int wc, int fr, int fq) const {
        const int row0 = u.pm * BM + wr * 64 + fr, col0 = u.pn * BM + wc * 32 + 8 * fq;
#pragma unroll
        for (int ai = 0; ai < 2; ++ai)
#pragma unroll
            for (int m = 0; m < 4; ++m) {
                const int row = row0 + ai * HALF + m * 16;
                const float rs = ssq ? rsqrtf(ssq[row] * (1.0f / 2048.0f) + RMS_EPS) : 1.0f;
                bf16_t* rowp = O + (size_t)row * ldc + col0;
#pragma unroll
                for (int bj = 0; bj < 2; ++bj) {
                    f32x4 v0 = acc[ai][bj][m][0] * rs, v1 = acc[ai][bj][m][1] * rs;
                    if (RELU2) {
#pragma unroll
                        for (int e = 0; e < 4; ++e) { float a = fmaxf(v0[e], 0.f), b = fmaxf(v1[e], 0.f); v0[e] = a * a; v1[e] = b * b; }
                    }
                    u32x4 w; w.x = cvt_pk_bf16(v0[0], v0[1]); w.y = cvt_pk_bf16(v0[2], v0[3]); w.z = cvt_pk_bf16(v1[0], v1[1]); w.w = cvt_pk_bf16(v1[2], v1[3]);
                    *(u32x4*)(rowp + bj * HALF) = w;
                }
            }
    }
};
struct EpiResid {
    static constexpr bool PERM = false, AFTER_DRAIN = false;
    const float* base; float* out; bf16_t* xb; float* ssq;
    __device__ __forceinline__ void operator()(const f32x4 (&acc)[2][2][4][2], const Unit& u, int wr, int wc, int fr, int fq) const {
        typedef unsigned u32x2 __attribute__((ext_vector_type(2)));
        const int row0 = u.pm * BM + wr * 64 + fr, col0 = u.pn * BM + wc * 32 + 4 * fq;
#pragma unroll
        for (int ai = 0; ai < 2; ++ai)
#pragma unroll
            for (int m = 0; m < 4; ++m) {
                const int row = row0 + ai * HALF + m * 16;
                const size_t off = (size_t)row * 2048 + col0;
                float s = 0.f;
#pragma unroll
                for (int bj = 0; bj < 2; ++bj)
#pragma unroll
                    for (int n = 0; n < 2; ++n) {
                        const f32x4 b = *(const f32x4*)(base + off + bj * HALF + n * 16);
                        const f32x4 v = b + acc[ai][bj][m][n];
                        *(f32x4*)(out + off + bj * HALF + n * 16) = v;
                        if (xb) { u32x2 w; w.x = cvt_pk_bf16(v[0], v[1]); w.y = cvt_pk_bf16(v[2], v[3]); *(u32x2*)(xb + off + bj * HALF + n * 16) = w; }
                        s += (v[0] * v[0] + v[1] * v[1]) + (v[2] * v[2] + v[3] * v[3]);
                    }
                if (ssq) { s += __shfl_xor(s, 16); s += __shfl_xor(s, 32); if (fq == 0) unsafeAtomicAdd(ssq + row, s); }
            }
    }
};
template <class Epi, class Sched, bool ALIGN_EPI = false, bool SP2 = false>
__device__ __forceinline__ void gemm_phase(PG8_LAS unsigned char* lds, const Gemm g, const Sched& S, const Epi& E) {
    int tid_ = threadIdx.x; asm volatile("" : "+v"(tid_));
    const int tid = tid_, wid = __builtin_amdgcn_readfirstlane(tid >> 6), lane = tid & 63, wr = wid >> 2, wc = wid & 3, fr = lane & 15, fq = lane >> 4;
    const int K = g.K, nt = K / BK;
    unsigned voffA[2], voffB[2];
#pragma unroll
    for (int i = 0; i < 2; ++i) { int R, C; stage_rc(tid * 16 + i * 8192, R, C); const int Rb = Epi::PERM ? ((R & ~31) + perm32(R & 31)) : R;
        voffA[i] = (unsigned)(R * g.lda + C) * 2u; voffB[i] = (unsigned)(Rb * K + C) * 2u; }
    const size_t kstep = (size_t)(BK * 2);
    const size_t hstepA = (size_t)HALF * g.lda * 2, hstepB = (size_t)HALF * K * 2;
    const size_t tstepA = 2 * hstepA, tstepB = 2 * hstepB;
    const unsigned ldsw = (unsigned)wid * 1024u;
    const int aoff = lds_byte(wr * 64 + fr, fq * 8), boff = lds_byte(wc * 32 + fr, fq * 8);
#define PG8_SA(b, h) (((b) * 2 + (h)) * HTB)
#define PG8_SB(b, h) ((4 + (b) * 2 + (h)) * HTB)
#define PG8_STAGE(bufoff, gbase, voff) do { _Pragma("unroll") for (int _i = 0; _i < 2; ++_i) \
        __builtin_amdgcn_global_load_lds((const unsigned*)((const char*)(gbase) + (voff)[_i]), (PG8_LAS unsigned*)(lds + (bufoff) + ldsw + _i * 8192), 16, 0, 0); } while (0)
#define PG8_LDA(dst, b, h) do { _Pragma("unroll") for (int m = 0; m < 4; ++m) _Pragma("unroll") for (int k = 0; k < 2; ++k) dst[m][k] = *(const PG8_LAS bf16x8*)(lds + PG8_SA(b, h) + aoff + m * 2048 + k * 1024); } while (0)
#define PG8_LDB(dst, b, h) do { _Pragma("unroll") for (int n = 0; n < 2; ++n) _Pragma("unroll") for (int k = 0; k < 2; ++k) dst[n][k] = *(const PG8_LAS bf16x8*)(lds + PG8_SB(b, h) + boff + n * 2048 + k * 1024); } while (0)
#define PG8_MMA(ai, bj, At, Bt) do { __builtin_amdgcn_s_setprio(1); _Pragma("unroll") for (int m = 0; m < 4; ++m) _Pragma("unroll") for (int n = 0; n < 2; ++n) _Pragma("unroll") for (int k = 0; k < 2; ++k) \
        acc[ai][bj][m][n] = __builtin_amdgcn_mfma_f32_16x16x32_bf16(Bt[n][k], At[m][k], acc[ai][bj][m][n], 0, 0, 0); __builtin_amdgcn_s_setprio(0); } while (0)
#define PG8_WAIT_V(n) asm volatile("s_waitcnt vmcnt(" #n ")" ::: "memory")
#define PG8_WAIT_L(n) asm volatile("s_waitcnt lgkmcnt(" #n ")" ::: "memory")
#define PG8_BAR __builtin_amdgcn_s_barrier()
#define PG8_SCHED __builtin_amdgcn_sched_barrier(0)
    Unit cur, nxt; int ui = 0;
    if (!S.next(0, cur)) return;
    f32x4 acc[2][2][4][2];
#pragma unroll
    for (int a = 0; a < 2; ++a)
#pragma unroll
        for (int b = 0; b < 2; ++b)
#pragma unroll
            for (int m = 0; m < 4; ++m)
#pragma unroll
                for (int n = 0; n < 2; ++n) acc[a][b][m][n] = (f32x4){0.f, 0.f, 0.f, 0.f};
    bf16x8 At[4][2], B0[2][2], B1[2][2];
    const char* cA = (const char*)g.A + (size_t)cur.pm * tstepA; const char* cB = (const char*)g.Bt + (size_t)cur.pn * tstepB;
    S.a_ready(cur);
    if constexpr (SP2) {
        PG8_STAGE(PG8_SB(0, 0), cB, voffB); PG8_STAGE(PG8_SB(0, 1), cB + hstepB, voffB); PG8_STAGE(PG8_SA(0, 0), cA, voffA); PG8_STAGE(PG8_SA(0, 1), cA + hstepA, voffA);
        if (wr == 1) PG8_BAR;
        PG8_WAIT_V(2); PG8_BAR;
        PG8_STAGE(PG8_SB(1, 0), cB + kstep, voffB); PG8_STAGE(PG8_SA(1, 0), cA + kstep, voffA); PG8_STAGE(PG8_SB(1, 1), cB + hstepB + kstep, voffB);
        PG8_WAIT_V(6); PG8_BAR;
    } else {
        PG8_STAGE(PG8_SB(0, 0), cB, voffB); PG8_STAGE(PG8_SA(0, 0), cA, voffA); PG8_STAGE(PG8_SB(0, 1), cB + hstepB, voffB); PG8_STAGE(PG8_SA(0, 1), cA + hstepA, voffA);
        if (wr == 1) PG8_BAR;
        PG8_WAIT_V(4); PG8_BAR;
        PG8_STAGE(PG8_SB(1, 0), cB + kstep, voffB); PG8_STAGE(PG8_SA(1, 0), cA + kstep, voffA); PG8_STAGE(PG8_SB(1, 1), cB + hstepB + kstep, voffB);
        PG8_WAIT_V(6); PG8_BAR;
    }
    for (;;) {
        const bool has_next = S.next(ui + 1, nxt);
        const char* nA = has_next ? (const char*)g.A + (size_t)nxt.pm * tstepA : cA; const char* nB = has_next ? (const char*)g.Bt + (size_t)nxt.pn * tstepB : cB;
        for (int t = 0; t < nt; t += 2) {
            const bool last = (t == nt - 2);
            const char* a1 = cA + (size_t)(t + 1) * kstep;
            const char* a2 = last ? nA : cA + (size_t)(t + 2) * kstep; const char* b2 = last ? nB : cB + (size_t)(t + 2) * kstep;
            const char* a3 = a2 + kstep; const char* b3 = b2 + kstep;
            if (last && has_next) S.a_ready(nxt);
            if constexpr (SP2) {
            PG8_LDB(B0, 0, 0); PG8_LDB(B1, 0, 1); PG8_SCHED; PG8_LDA(At, 0, 0); PG8_STAGE(PG8_SA(1, 1), a1 + hstepA, voffA);
            PG8_WAIT_V(8); PG8_WAIT_L(0); PG8_BAR; PG8_MMA(0, 0, At, B0); PG8_MMA(0, 1, At, B1); PG8_BAR; PG8_SCHED;
            PG8_LDA(At, 0, 1); PG8_STAGE(PG8_SB(0, 0), b2, voffB); PG8_STAGE(PG8_SB(0, 1), b2 + hstepB, voffB); PG8_STAGE(PG8_SA(0, 0), a2, voffA);
            PG8_WAIT_V(8); PG8_WAIT_L(0); PG8_BAR; PG8_MMA(1, 0, At, B0); PG8_MMA(1, 1, At, B1); PG8_BAR; PG8_SCHED;
            PG8_LDB(B0, 1, 0); PG8_LDB(B1, 1, 1); PG8_SCHED; PG8_LDA(At, 1, 0); PG8_STAGE(PG8_SA(0, 1), a2 + hstepA, voffA);
            PG8_WAIT_V(8); PG8_WAIT_L(0); PG8_BAR; PG8_MMA(0, 0, At, B0); PG8_MMA(0, 1, At, B1); PG8_BAR; PG8_SCHED;
            PG8_LDA(At, 1, 1); PG8_STAGE(PG8_SB(1, 0), b3, voffB); PG8_STAGE(PG8_SB(1, 1), b3 + hstepB, voffB); PG8_STAGE(PG8_SA(1, 0), a3, voffA);
            PG8_WAIT_V(8); PG8_WAIT_L(0); PG8_BAR; PG8_MMA(1, 0, At, B0); PG8_MMA(1, 1, At, B1); PG8_BAR; PG8_SCHED;
            } else {
            PG8_LDB(B0, 0, 0); PG8_SCHED; PG8_LDA(At, 0, 0); PG8_STAGE(PG8_SA(1, 1), a1 + hstepA, voffA);
            PG8_WAIT_L(8); PG8_BAR; PG8_WAIT_L(0); PG8_MMA(0, 0, At, B0); PG8_BAR; PG8_SCHED;
            PG8_LDB(B1, 0, 1); PG8_STAGE(PG8_SB(0, 0), b2, voffB);
            PG8_BAR; PG8_WAIT_L(0); PG8_MMA(0, 1, At, B1); PG8_BAR;
            PG8_LDA(At, 0, 1); PG8_STAGE(PG8_SA(0, 0), a2, voffA);
            PG8_BAR; PG8_WAIT_L(0); PG8_MMA(1, 0, At, B0); PG8_BAR; PG8_SCHED;
            PG8_STAGE(PG8_SB(0, 1), b2 + hstepB, voffB);
            PG8_WAIT_V(6); PG8_BAR; PG8_MMA(1, 1, At, B1); PG8_BAR;
            PG8_LDB(B0, 1, 0); PG8_SCHED; PG8_LDA(At, 1, 0); PG8_STAGE(PG8_SA(0, 1), a2 + hstepA, voffA);
            PG8_WAIT_L(8); PG8_BAR; PG8_WAIT_L(0); PG8_MMA(0, 0, At, B0); PG8_BAR; PG8_SCHED;
            PG8_LDB(B1, 1, 1); PG8_STAGE(PG8_SB(1, 0), b3, voffB);
            PG8_BAR; PG8_WAIT_L(0); PG8_MMA(0, 1, At, B1); PG8_BAR;
            PG8_LDA(At, 1, 1); PG8_STAGE(PG8_SA(1, 0), a3, voffA);
            PG8_BAR; PG8_WAIT_L(0); PG8_MMA(1, 0, At, B0); PG8_BAR; PG8_SCHED;
            PG8_STAGE(PG8_SB(1, 1), b3 + hstepB, voffB);
            PG8_WAIT_V(6); PG8_BAR; PG8_MMA(1, 1, At, B1); PG8_BAR;
            }
        }
        if constexpr (ALIGN_EPI) { if (wr == 0) PG8_BAR; }
        if constexpr (!Epi::AFTER_DRAIN) { E(acc, cur, wr, wc, fr, fq); S.done(cur); }
        if (!has_next) break;
#pragma unroll
        for (int a = 0; a < 2; ++a)
#pragma unroll
            for (int b = 0; b < 2; ++b)
#pragma unroll
                for (int m = 0; m < 4; ++m)
#pragma unroll
                    for (int n = 0; n < 2; ++n) acc[a][b][m][n] = (f32x4){0.f, 0.f, 0.f, 0.f};
        cur = nxt; cA = nA; cB = nB; ++ui;
        if constexpr (ALIGN_EPI) { if (wr == 1) PG8_BAR; }
    }
    PG8_WAIT_V(0);
    if constexpr (!ALIGN_EPI) { if (wr == 0) PG8_BAR; }
    PG8_BAR;
    if constexpr (Epi::AFTER_DRAIN) { E.fused(acc, cur, wr, wc, fr, fq, lds, wid, lane); S.done(cur); }
#undef PG8_SA
#undef PG8_SB
#undef PG8_STAGE
#undef PG8_LDA
#undef PG8_LDB
#undef PG8_MMA
#undef PG8_WAIT_V
#undef PG8_WAIT_L
#undef PG8_BAR
#undef PG8_SCHED
}
}

#define LAS __attribute__((address_space(3)))
typedef unsigned short bf16_t;
typedef short bf16x8 __attribute__((ext_vector_type(8)));
typedef short s16x4 __attribute__((ext_vector_type(4)));
typedef float f32x4 __attribute__((ext_vector_type(4)));
typedef float f32x16 __attribute__((ext_vector_type(16)));
typedef unsigned u32x4 __attribute__((ext_vector_type(4)));
typedef unsigned u32x2 __attribute__((ext_vector_type(2)));
typedef float f32x2 __attribute__((ext_vector_type(2)));

constexpr int SEQ = 8192, DM = 2048, DFF = 8192, NIN = 4678, NINP = 4864, NQUP = 1152, NQUPP = 1280, NKVUP = 1536;
constexpr int C_DQ = 0, C_DK = 512, C_DV = 1024, C_FQ = 1536, C_FK = 2304, C_FV = 3072, C_MQ = 3840, C_CKV = 4352, C_KR = 4608, C_FF = 4672;
constexpr size_t MiB = 1u << 20;
constexpr size_t WS_CNT = 0, WS_LAM = 128, WS_TABLE = 4096, WS_BAR = 16384, WS_SSQ = 64 * 1024, WS_LOGF = 256 * 1024, WS_CUM = 512 * 1024;
constexpr size_t WS_COSP = 1 * MiB, WS_SINP = 1 * MiB + 256 * 1024, WS_COSM = 2 * MiB, WS_SINM = 3 * MiB;
constexpr size_t WS_WIN = 4 * MiB, SZ_WIN = 19 * MiB, WS_WOUT = 42 * MiB, SZ_WOUT = 8 * MiB, WS_WUP = 58 * MiB, SZ_WUP = 32 * MiB, WS_WDN = 122 * MiB, SZ_WDN = 32 * MiB;
constexpr size_t WS_WQUP = 186 * MiB, SZ_WQUP = (size_t)NQUPP * 512 * 2, WS_WKVUP = 189 * MiB, SZ_WKVUP = (size_t)NKVUP * 256 * 2;
constexpr size_t WS_XB = 192 * MiB, WS_XF = 224 * MiB, WS_MIX = 288 * MiB, WS_PROJ = 320 * MiB, WS_QC = 396 * MiB, WS_KVC = 416 * MiB, WS_H = 320 * MiB, WS_END = 448 * MiB;
#ifndef ATT_SPLIT
#define ATT_SPLIT 0
#endif
constexpr int NUNITS = ATT_SPLIT ? 1024 : 640;
constexpr int LDS_BYTES = 131072 + 4096;
constexpr float LOG2E = 1.4426950408889634f;

struct Args {
    const float* in[23];
    float* out; unsigned char* ws;
    int ph_lo, ph_hi;
};
typedef const __attribute__((address_space(4))) Args* ArgsP;
enum { I_X = 0, I_NORM_MIX, I_W_IN, I_DQN, I_DKN, I_LQ1, I_LK1, I_LQ2, I_LK2, I_SUBLN, I_FQN, I_FKN, I_FBIAS, I_QAN, I_KVAN, I_WQUP, I_WKVUP, I_MQN, I_MKN, I_WOUT, I_NORM_FFN, I_WUP, I_WDN };

typedef float cvt_f32x2 __attribute__((ext_vector_type(2))); typedef __bf16 cvt_bf16x2 __attribute__((ext_vector_type(2)));
__device__ __forceinline__ unsigned cvtpk(float lo, float hi) { const cvt_f32x2 v = {lo, hi}; const cvt_bf16x2 r = __builtin_convertvector(v, cvt_bf16x2); return __builtin_bit_cast(unsigned, r); }
__device__ __forceinline__ float bflo(unsigned w) { return __uint_as_float(w << 16); }
__device__ __forceinline__ float bfhi(unsigned w) { return __uint_as_float(w & 0xffff0000u); }
__device__ __forceinline__ float wave_sum(float v) {
#pragma unroll
    for (int o = 1; o < 64; o <<= 1) v += __shfl_xor(v, o);
    return v;
}

#define XB_TMO      128
#define XB_XCNT(j)  (256  + 64 * (j))
#define XB_XSUB(j)  (1280 + 64 * (j))
#define XB_XGEN(j)  (2304 + 64 * (j))
#define XB_TOP      3328
#define XB_TOPGEN   3392
#define XCD_BAR_WORDS 3456
#define XB_SPIN_CAP (1u << 18)

__device__ __forceinline__ unsigned xb_ld(unsigned* p)              { return __hip_atomic_load(p, __ATOMIC_RELAXED, __HIP_MEMORY_SCOPE_AGENT); }
__device__ __forceinline__ unsigned xb_add(unsigned* p, unsigned v) { return __hip_atomic_fetch_add(p, v, __ATOMIC_RELAXED, __HIP_MEMORY_SCOPE_AGENT); }
__device__ __forceinline__ unsigned xb_xcc_id() { return (unsigned)__builtin_amdgcn_s_getreg((3 << 11) | 20) & 0xFu; }
#define XB_SPIN(cond, bar) do { unsigned _sp = 0; while (cond) { __builtin_amdgcn_s_sleep(1); \
    if ((++_sp & 255u) == 0u) { if (xb_ld(&(bar)[XB_TMO])) break; if (_sp > XB_SPIN_CAP) { atomicAdd(&(bar)[XB_TMO], 1u); break; } } } } while (0)

struct XcdBarrier {
    unsigned* bar; unsigned x;
    volatile LAS unsigned* st;
};

__device__ __forceinline__ XcdBarrier xcd_barrier_post(unsigned* bar, volatile LAS unsigned* st) {
    XcdBarrier b; b.bar = bar; b.x = xb_xcc_id(); b.st = st;
    if (threadIdx.x == 0) (void)xb_add(&bar[XB_XCNT(b.x)], 1u);
    return b;
}
__device__ __forceinline__ void xcd_barrier_complete(unsigned* bar, unsigned x, unsigned& nloc, unsigned& nx) {
    const unsigned G = gridDim.x * gridDim.y * gridDim.z;
    unsigned sum, cnt, mine, sp = 0u;
    for (;;) {
        sum = 0u; cnt = 0u; mine = 0u;
#pragma unroll
        for (unsigned j = 0; j < 16; ++j) { const unsigned c = xb_ld(&bar[XB_XCNT(j)]); sum += c; cnt += (c > 0u) ? 1u : 0u; mine = (j == x) ? c : mine; }
        if (sum == G) break;
        __builtin_amdgcn_s_sleep(1);
        if ((++sp & 255u) == 0u) { if (xb_ld(&bar[XB_TMO])) break; if (sp > XB_SPIN_CAP) { atomicAdd(&bar[XB_TMO], 1u); break; } }
    }
    nloc = mine > 0u ? mine : 1u; nx = cnt > 0u ? cnt : 1u;
}

__device__ __forceinline__ void xcd_barrier(const XcdBarrier& b) {
    asm volatile("s_waitcnt vmcnt(0)" ::: "memory");
    __syncthreads();
    if (threadIdx.x == 0) {
        unsigned* bar = b.bar;
        __builtin_amdgcn_s_waitcnt(0);
        unsigned nloc = b.st[0], nx = b.st[1];
        if (nloc == 0u) { xcd_barrier_complete(bar, b.x, nloc, nx); b.st[0] = nloc; b.st[1] = nx; }
        const unsigned old = xb_add(&bar[XB_XSUB(b.x)], 1u);
        const unsigned gen = old / nloc;
        if (old + 1u == (gen + 1u) * nloc) {
            __builtin_amdgcn_fence(__ATOMIC_RELEASE, "agent");
            asm volatile("s_waitcnt vmcnt(0)" ::: "memory");
            const unsigned og = xb_add(&bar[XB_TOP], 1u);
            const unsigned tg = og / nx;
            if (og + 1u == (tg + 1u) * nx) xb_add(&bar[XB_TOPGEN], 1u);
            else XB_SPIN(xb_ld(&bar[XB_TOPGEN]) == tg, bar);
            __builtin_amdgcn_fence(__ATOMIC_ACQUIRE, "agent");
            xb_add(&bar[XB_XGEN(b.x)], 1u);
            asm volatile("s_waitcnt vmcnt(0)" ::: "memory");
        } else {
            XB_SPIN(xb_ld(&bar[XB_XGEN(b.x)]) == gen, bar);
            __builtin_amdgcn_fence(__ATOMIC_ACQUIRE, "agent");
            asm volatile("s_waitcnt vmcnt(0)" ::: "memory");
        }
    }
    __syncthreads();
}


template <int MAP>
__device__ __forceinline__ void tr_item(const float* __restrict__ W, int K, int N, const float* __restrict__ gain, bf16_t* WT, LAS float* scr, int item, int lane) {
    const int nblk = (N + 31) / 32, kb = item / nblk, nb = item % nblk, k0 = 64 * kb, n0 = 32 * nb;
    const int nsrc = n0 + (lane & 31); const bool ok = nsrc < N;
    float v[32];
#pragma unroll
    for (int i = 0; i < 32; ++i) { const int kk = 2 * i + (lane >> 5); v[i] = ok ? __builtin_nontemporal_load(W + (size_t)(k0 + kk) * N + nsrc) : 0.f; }
#pragma unroll
    for (int i = 0; i < 32; ++i) { const int kk = 2 * i + (lane >> 5); float x = v[i]; if (gain) x *= gain[k0 + kk]; scr[kk * 33 + (lane & 31)] = x; }
    asm volatile("s_waitcnt lgkmcnt(0)" ::: "memory");
    const int c = lane & 7;
#pragma unroll
    for (int j = 0; j < 4; ++j) {
        const int nl = (lane >> 3) + 8 * j, n = n0 + nl;
        const LAS float* s = scr + (8 * c) * 33 + nl;
        u32x4 o; o.x = cvtpk(s[0 * 33], s[1 * 33]); o.y = cvtpk(s[2 * 33], s[3 * 33]); o.z = cvtpk(s[4 * 33], s[5 * 33]); o.w = cvtpk(s[6 * 33], s[7 * 33]);
        int dest = n;
        if (MAP == 1) { if (n >= 3846) dest = n - 6; else if (n >= 3840) dest = C_FF + (n - 3840); }
        if (n < N) *(u32x4*)(WT + (size_t)dest * K + k0 + 8 * c) = o;
    }
    asm volatile("s_waitcnt lgkmcnt(0)" ::: "memory");
}

constexpr int TR_IT_IN = (DM / 64) * ((NIN + 31) / 32), TR_IT_OUT = (DM / 64) * (DM / 32), TR_IT_UP = (DM / 64) * (DFF / 32), TR_IT_DN = (DFF / 64) * (DM / 32);
constexpr int TR_IT_QUP = (512 / 64) * (NQUP / 32), TR_IT_KVUP = (256 / 64) * (NKVUP / 32);
constexpr int TR_PER_L = TR_IT_IN + TR_IT_OUT + TR_IT_UP + TR_IT_DN + TR_IT_QUP + TR_IT_KVUP;
constexpr int TR_CHUNK = 32;
constexpr int TR_N_EARLY = TR_IT_IN + TR_IT_QUP + TR_IT_KVUP, TR_N_LATE = TR_IT_OUT + TR_IT_UP + TR_IT_DN;
__device__ __forceinline__ int tr_early_item(int i) { return i < TR_IT_IN ? i : i + TR_N_LATE; }
__device__ __forceinline__ int tr_late_item(int i) { return i + TR_IT_IN; }
__device__ __forceinline__ void tr_dispatch(ArgsP a, int l, int r, LAS float* scr, int lane) {
    unsigned char* ws = a->ws;
    if (r < TR_IT_IN) { tr_item<1>(a->in[I_W_IN] + (size_t)l * DM * NIN, DM, NIN, a->in[I_NORM_MIX] + l * DM, (bf16_t*)(ws + WS_WIN + l * SZ_WIN), scr, r, lane); return; } r -= TR_IT_IN;
    if (r < TR_IT_OUT) { tr_item<0>(a->in[I_WOUT] + (size_t)l * DM * DM, DM, DM, nullptr, (bf16_t*)(ws + WS_WOUT + l * SZ_WOUT), scr, r, lane); return; } r -= TR_IT_OUT;
    if (r < TR_IT_UP) { tr_item<0>(a->in[I_WUP] + (size_t)l * DM * DFF, DM, DFF, a->in[I_NORM_FFN] + l * DM, (bf16_t*)(ws + WS_WUP + l * SZ_WUP), scr, r, lane); return; } r -= TR_IT_UP;
    if (r < TR_IT_DN) { tr_item<0>(a->in[I_WDN] + (size_t)l * DFF * DM, DFF, DM, nullptr, (bf16_t*)(ws + WS_WDN + l * SZ_WDN), scr, r, lane); return; } r -= TR_IT_DN;
    if (r < TR_IT_QUP) { tr_item<0>(a->in[I_WQUP] + (size_t)l * 512 * NQUP, 512, NQUP, a->in[I_QAN] + l * 512, (bf16_t*)(ws + WS_WQUP + l * SZ_WQUP), scr, r, lane); return; } r -= TR_IT_QUP;
    tr_item<0>(a->in[I_WKVUP] + (size_t)l * 256 * NKVUP, 256, NKVUP, a->in[I_KVAN] + l * 256, (bf16_t*)(ws + WS_WKVUP + l * SZ_WKVUP), scr, r, lane);
}
__device__ __forceinline__ void prologue(ArgsP a, LAS unsigned char* lds) {
    int tid_ = threadIdx.x; asm volatile("" : "+v"(tid_));
    const int tid = tid_, lane = tid & 63, wave = __builtin_amdgcn_readfirstlane(tid >> 6);
    const int G = gridDim.x, gw = blockIdx.x * 8 + wave, NGW = G * 8;
    unsigned char* ws = a->ws;
    if (blockIdx.x == 0) {
        if (tid < 32) ((int*)(ws + WS_CNT))[tid] = 0;
        if (tid >= 64 && tid < 66) {
            const int l = tid - 64; float s1 = 0.f, s2 = 0.f;
            for (int i = 0; i < 64; ++i) { s1 += a->in[I_LQ1][l * 64 + i] * a->in[I_LK1][l * 64 + i]; s2 += a->in[I_LQ2][l * 64 + i] * a->in[I_LK2][l * 64 + i]; }
            const float linit = 0.8f - 0.6f * expf(-0.3f * (float)l);
            ((float*)(ws + WS_LAM))[l] = expf(s1) - expf(s2) + linit;
        }
        if (tid >= 66 && tid < 68) {
            const int l = tid - 66; float gq = 0.f, gk = 0.f;
            for (int i = 0; i < 128; ++i) { gq = fmaxf(gq, fabsf(a->in[I_FQN][l * 128 + i])); gk = fmaxf(gk, fabsf(a->in[I_FKN][l * 128 + i])); }
            ((float*)(ws + WS_LAM))[8 + l] = 11.3137085f * gq * gk * 1.4426950408889634f * 1.02f;
        }
        if (tid >= 68 && tid < 70) {
            const int l = tid - 68; float gq = 0.f, gk = 0.f, qr_ = 0.f, qn = 0.f, kr = 0.f, kn = 0.f;
            for (int i = 0; i < 64; ++i) { gq = fmaxf(gq, fabsf(a->in[I_DQN][l * 64 + i])); gk = fmaxf(gk, fabsf(a->in[I_DKN][l * 64 + i])); }
            ((float*)(ws + WS_LAM))[12 + l] = 8.0f * gq * gk * 1.4426950408889634f * 1.02f;
            for (int i = 0; i < 64; ++i) { qr_ = fmaxf(qr_, fabsf(a->in[I_MQN][l * 192 + i])); kr = fmaxf(kr, fabsf(a->in[I_MKN][l * 192 + i])); }
            for (int i = 64; i < 192; ++i) { qn = fmaxf(qn, fabsf(a->in[I_MQN][l * 192 + i])); kn = fmaxf(kn, fabsf(a->in[I_MKN][l * 192 + i])); }
            ((float*)(ws + WS_LAM))[16 + l] = sqrtf(64.f * qr_ * qr_ + 128.f * qn * qn) * sqrtf(64.f * kr * kr + 128.f * kn * kn) * 0.07216878364870322f * 1.4426950408889634f * 1.02f;
        }
        for (int id = tid; id < NUNITS; id += 512) {
            auto cost = [](int u) { constexpr int Q = ATT_SPLIT ? 64 : 32, NB = 256 + 6 * Q;
                                    return u < 256 ? 48 * ((u & 63) + 1) : (u < NB ? (ATT_SPLIT ? 16 : 64) * (((u - 256) % Q) + 1) : (ATT_SPLIT ? 40 : 160) * (((u - NB) % Q) + 1)); };
            const int mine = cost(id); int rank = 0;
            for (int j = 0; j < NUNITS; ++j) { const int cj = cost(j); rank += (cj > mine || (cj == mine && j < id)) ? 1 : 0; }
            ((int*)(ws + WS_TABLE))[rank] = id;
        }
    }
    {
        float* cosp = (float*)(ws + WS_COSP); float* sinp = (float*)(ws + WS_SINP); float* cosm = (float*)(ws + WS_COSM); float* sinm = (float*)(ws + WS_SINM);
        const int gt = blockIdx.x * 512 + tid, NT = G * 512;
        for (int i = gt; i < SEQ * 40; i += NT) {
            const int pos = i / 40, j = i % 40;
            if (j < 8) { const float inv = (float)pow(500000.0, -(double)j / 8.0); const float ang = (float)pos * inv; cosp[pos * 8 + j] = (float)cos((double)ang); sinp[pos * 8 + j] = (float)sin((double)ang); }
            else { const int jj = j - 8; const float inv = (float)pow(500000.0, -(double)jj / 32.0); const float ang = (float)pos * inv; cosm[pos * 32 + jj] = (float)cos((double)ang); sinm[pos * 32 + jj] = (float)sin((double)ang); }
        }
    }
    {
        const float* x = a->in[I_X]; bf16_t* xb = (bf16_t*)(ws + WS_XB); float* ssq = (float*)(ws + WS_SSQ);
        for (int m = gw; m < SEQ; m += NGW) {
            const f32x4* xr = (const f32x4*)(x + (size_t)m * DM) + lane; u32x2* o = (u32x2*)(xb + (size_t)m * DM) + lane; float s = 0.f;
#pragma unroll
            for (int j = 0; j < 8; ++j) { const f32x4 v = __builtin_nontemporal_load(xr + 64 * j); s += (v[0] * v[0] + v[1] * v[1]) + (v[2] * v[2] + v[3] * v[3]); u32x2 w; w.x = cvtpk(v[0], v[1]); w.y = cvtpk(v[2], v[3]); o[64 * j] = w; }
            s = wave_sum(s);
            if (lane == 0) ssq[m] = s;
            if (lane >= 1 && lane < 4) ssq[lane * SEQ + m] = 0.f;
        }
    }
    {
        LAS float* scr = (LAS float*)(lds + wave * 8704);
        for (int it = gw; it < TR_N_EARLY; it += NGW) tr_dispatch(a, 0, tr_early_item(it), scr, lane);
    }
}

__device__ __forceinline__ void unpack8(const u32x4 w, float* f) { f[0] = bflo(w.x); f[1] = bfhi(w.x); f[2] = bflo(w.y); f[3] = bfhi(w.y); f[4] = bflo(w.z); f[5] = bfhi(w.z); f[6] = bflo(w.w); f[7] = bfhi(w.w); }
__device__ __forceinline__ u32x4 pack8f(const float* f) { u32x4 w; w.x = cvtpk(f[0], f[1]); w.y = cvtpk(f[2], f[3]); w.z = cvtpk(f[4], f[5]); w.w = cvtpk(f[6], f[7]); return w; }

__device__ __forceinline__ void post_proj_row(ArgsP a, int l, int row, int lane) {
    unsigned char* ws = a->ws;
    bf16_t* P = (bf16_t*)(ws + WS_PROJ) + (size_t)row * NINP;
    const u32x4 ld_d0 = *(const u32x4*)(P + 16 * lane), ld_d1 = *(const u32x4*)(P + 16 * lane + 8);
    const u32x4 ld_f0 = *(const u32x4*)(P + C_FQ + 8 * lane), ld_f1 = *(const u32x4*)(P + C_FQ + 512 + 8 * lane), ld_f2 = *(const u32x4*)(P + C_FQ + 1024 + 8 * lane);
    const u32x4 ld_q = *(const u32x4*)(P + C_MQ + 8 * lane);
    const u32x2 ld_c = *(const u32x2*)(P + C_CKV + 4 * lane);
    const u32x4 ld_k = *(const u32x4*)(P + C_KR + 8 * (lane & 7));
    const unsigned short ld_ff = P[C_FF + (lane < 6 ? lane : 0)];
    {
        float x[16]; unpack8(ld_d0, x); unpack8(ld_d1, x + 8);
        float ss = 0.f;
#pragma unroll
        for (int i = 0; i < 16; ++i) ss += x[i] * x[i];
        ss += __shfl_xor(ss, 1); ss += __shfl_xor(ss, 2);
        const float rstd = rsqrtf(ss * (1.0f / 64.0f) + RMS_EPS);
        const float* g = (lane < 32 ? a->in[I_DQN] : a->in[I_DKN]) + l * 64 + (lane & 3) * 16;
        const float rq = rstd;
#pragma unroll
        for (int i = 0; i < 16; ++i) x[i] = x[i] * rq * g[i];
        if ((lane & 3) == 0) {
            const float* cp = (const float*)(ws + WS_COSP) + row * 8; const float* sp = (const float*)(ws + WS_SINP) + row * 8;
#pragma unroll
            for (int i = 0; i < 8; ++i) { const float x1 = x[i], x2 = x[i + 8], c = cp[i], s = sp[i]; x[i] = x1 * c - x2 * s; x[i + 8] = x2 * c + x1 * s; }
        }
        *(u32x4*)(P + 16 * lane) = pack8f(x); *(u32x4*)(P + 16 * lane + 8) = pack8f(x + 8);
    }
#pragma unroll
    for (int p = 0; p < 3; ++p) {
        const int rel = 512 * p + 8 * lane;
        float x[8]; unpack8(p == 0 ? ld_f0 : (p == 1 ? ld_f1 : ld_f2), x);
        float ss = 0.f;
#pragma unroll
        for (int i = 0; i < 8; ++i) ss += x[i] * x[i];
        ss += __shfl_xor(ss, 1); ss += __shfl_xor(ss, 2); ss += __shfl_xor(ss, 4); ss += __shfl_xor(ss, 8);
        const float rstd = rsqrtf(ss * (1.0f / 128.0f) + RMS_EPS);
        const float* g = (rel < 768 ? a->in[I_FQN] : a->in[I_FKN]) + l * 128 + (rel & 127);
        const float rq = rstd;
#pragma unroll
        for (int i = 0; i < 8; ++i) x[i] = x[i] * rq * g[i];
        *(u32x4*)(P + C_FQ + rel) = pack8f(x);
    }
    {
        float x[8]; unpack8(ld_q, x);
        float ss = 0.f;
#pragma unroll
        for (int i = 0; i < 8; ++i) ss += x[i] * x[i];
        ss = wave_sum(ss);
        const float rstd = rsqrtf(ss * (1.0f / 512.0f) + RMS_EPS);
#pragma unroll
        for (int i = 0; i < 8; ++i) x[i] *= rstd;
        *(u32x4*)(P + C_MQ + 8 * lane) = pack8f(x);
    }
    {
        const u32x2 w0 = ld_c;
        float x0 = bflo(w0.x), x1 = bfhi(w0.x), x2 = bflo(w0.y), x3 = bfhi(w0.y);
        float ss = wave_sum((x0 * x0 + x1 * x1) + (x2 * x2 + x3 * x3));
        const float rstd = rsqrtf(ss * (1.0f / 256.0f) + RMS_EPS);
        u32x2 o; o.x = cvtpk(x0 * rstd, x1 * rstd); o.y = cvtpk(x2 * rstd, x3 * rstd);
        *(u32x2*)(P + C_CKV + 4 * lane) = o;
    }
    {
        const int j = lane & 7;
        float x[8]; unpack8(ld_k, x);
        float ss = 0.f;
#pragma unroll
        for (int i = 0; i < 8; ++i) ss += x[i] * x[i];
        ss += __shfl_xor(ss, 1); ss += __shfl_xor(ss, 2); ss += __shfl_xor(ss, 4);
        const float rstd = rsqrtf(ss * (1.0f / 64.0f) + RMS_EPS);
        const float* g = a->in[I_MKN] + l * 192 + 8 * j;
        const float* cp = (const float*)(ws + WS_COSM) + row * 32 + 8 * (j & 3); const float* sp = (const float*)(ws + WS_SINM) + row * 32 + 8 * (j & 3);
        float y[8];
#pragma unroll
        for (int i = 0; i < 8; ++i) {
            const float mine = x[i] * rstd * g[i]; const float other = __shfl_xor(mine, 4);
            y[i] = (j < 4) ? (mine * cp[i] - other * sp[i]) : (mine * cp[i] + other * sp[i]);
        }
        if (lane < 8) *(u32x4*)(P + C_KR + 8 * j) = pack8f(y);
    }
    if (lane < 6) {
        const float z = __uint_as_float((unsigned)ld_ff << 16) + a->in[I_FBIAS][l * 6 + lane];
        const float lf = fminf(z, 0.f) - log1pf(expf(-fabsf(z)));
        ((float*)(ws + WS_LOGF))[row * 8 + lane] = lf;
    }
}

__device__ __forceinline__ void fox_cumsum(ArgsP a, int h, LAS unsigned char* lds) {
    int tid_ = threadIdx.x; asm volatile("" : "+v"(tid_));
    const int tid = tid_, lane = tid & 63, wave = tid >> 6;
    const float* lf = (const float*)(a->ws + WS_LOGF); float* cum = (float*)(a->ws + WS_CUM);
    double v[16]; double loc = 0.0;
#pragma unroll
    for (int i = 0; i < 16; ++i) { loc += (double)lf[(16 * tid + i) * 8 + h]; v[i] = loc; }
    double inc = loc;
#pragma unroll
    for (int o = 1; o < 64; o <<= 1) { const double t = __shfl_up(inc, o); if (lane >= o) inc += t; }
    LAS double* wt = (LAS double*)lds;
    if (lane == 63) wt[wave] = inc;
    __syncthreads();
    double pre = inc - loc;
    for (int w = 0; w < wave; ++w) pre += wt[w];
#pragma unroll
    for (int i = 0; i < 16; ++i) cum[(16 * tid + i) * 8 + h] = (float)((pre + v[i]) * 1.4426950408889634);
    __syncthreads();
}

__device__ __forceinline__ void post_mla_row(ArgsP a, int l, int row, int lane) {
    unsigned char* ws = a->ws;
    bf16_t* Q = (bf16_t*)(ws + WS_QC) + (size_t)row * NQUPP;
    bf16_t* KV = (bf16_t*)(ws + WS_KVC) + (size_t)row * NKVUP;
    const int g_r = (lane >> 3) < 6 ? (lane >> 3) : 0;
    const u32x4 ld_r = *(const u32x4*)(Q + g_r * 192 + 8 * (lane & 7));
    const int g_n0 = lane >> 4, g_n1 = (4 + (lane >> 4)) < 6 ? 4 + (lane >> 4) : 0;
    const u32x4 ld_qn0 = *(const u32x4*)(Q + g_n0 * 192 + 64 + 8 * (lane & 15)), ld_qn1 = *(const u32x4*)(Q + g_n1 * 192 + 64 + 8 * (lane & 15));
    const u32x4 ld_kn0 = *(const u32x4*)(KV + g_n0 * 256 + 8 * (lane & 15)), ld_kn1 = *(const u32x4*)(KV + g_n1 * 256 + 8 * (lane & 15));
    {
        const int g = lane >> 3, j = lane & 7; const bool act = g < 6;
        float x[8]; unpack8(ld_r, x);
        float ss = 0.f;
#pragma unroll
        for (int i = 0; i < 8; ++i) ss += x[i] * x[i];
        ss += __shfl_xor(ss, 1); ss += __shfl_xor(ss, 2); ss += __shfl_xor(ss, 4);
        const float rstd = rsqrtf(ss * (1.0f / 64.0f) + RMS_EPS);
        const float* gn = a->in[I_MQN] + l * 192 + 8 * j;
        const float* cp = (const float*)(ws + WS_COSM) + row * 32 + 8 * (j & 3); const float* sp = (const float*)(ws + WS_SINM) + row * 32 + 8 * (j & 3);
        float y[8];
#pragma unroll
        for (int i = 0; i < 8; ++i) {
            const float mine = x[i] * rstd * gn[i]; const float other = __shfl_xor(mine, 4);
            y[i] = (j < 4) ? (mine * cp[i] - other * sp[i]) : (mine * cp[i] + other * sp[i]);
        }
        if (act) *(u32x4*)(Q + g * 192 + 8 * j) = pack8f(y);
    }
#pragma unroll
    for (int p = 0; p < 2; ++p) {
        const int g = 4 * p + (lane >> 4), j = lane & 15; const bool act = g < 6; const int gg = act ? g : 0;
        {
            bf16_t* ptr = Q + gg * 192 + 64 + 8 * j;
            float x[8]; unpack8(p == 0 ? ld_qn0 : ld_qn1, x);
            float ss = 0.f;
#pragma unroll
            for (int i = 0; i < 8; ++i) ss += x[i] * x[i];
            ss += __shfl_xor(ss, 1); ss += __shfl_xor(ss, 2); ss += __shfl_xor(ss, 4); ss += __shfl_xor(ss, 8);
            const float rstd = rsqrtf(ss * (1.0f / 128.0f) + RMS_EPS);
            const float* gn = a->in[I_MQN] + l * 192 + 64 + 8 * j;
#pragma unroll
            for (int i = 0; i < 8; ++i) x[i] = x[i] * rstd * gn[i];
            if (act) *(u32x4*)ptr = pack8f(x);
        }
        {
            bf16_t* ptr = KV + gg * 256 + 8 * j;
            float x[8]; unpack8(p == 0 ? ld_kn0 : ld_kn1, x);
            float ss = 0.f;
#pragma unroll
            for (int i = 0; i < 8; ++i) ss += x[i] * x[i];
            ss += __shfl_xor(ss, 1); ss += __shfl_xor(ss, 2); ss += __shfl_xor(ss, 4); ss += __shfl_xor(ss, 8);
            const float rstd = rsqrtf(ss * (1.0f / 128.0f) + RMS_EPS);
            const float* gn = a->in[I_MKN] + l * 192 + 64 + 8 * j;
#pragma unroll
            for (int i = 0; i < 8; ++i) x[i] = x[i] * rstd * gn[i];
            if (act) *(u32x4*)ptr = pack8f(x);
        }
    }
}

#define SBAR() __builtin_amdgcn_sched_barrier(0)
__device__ __forceinline__ int v_st(int k, int c) { const int kk = (k & ~0xC) | ((k & 4) << 1) | ((k & 8) >> 1); return ((kk >> 3) * 4 + (c >> 5)) * 512 + ((kk & 7) * 32 + (c & 31)) * 2; }
__device__ __forceinline__ int v_rd_base(int lane) { return ((lane & 3) << 3) | (((lane >> 2) & 3) << 6) | (((lane >> 4) & 1) << 5) | (((lane >> 5) & 1) << 8); }
__device__ __forceinline__ int crow(int r, int hi) { return (r & 3) + 8 * (r >> 2) + 4 * hi; }

template <int KW> __device__ __forceinline__ int kswz(int row) {
    return KW == 128 ? (((row & 7) | (((row >> 4) & 1) << 3)) << 4) : ((((row >> 1) & 1) | (((row >> 2) & 1) << 1) | (((row >> 4) & 1) << 2)) << 4);
}
struct AttnP {
    const bf16_t* Q; int qpitch;
    const bf16_t* K0; int k0pitch;
    const bf16_t* K1; int k1pitch;
    const bf16_t* V; int vpitch;
    const float* cum;
    bf16_t* O;
    int P0, rows;
};

__device__ __forceinline__ void pv_tile(f32x16* o, unsigned vb, bf16x8 pa0, bf16x8 pa1, bf16x8 pa2, bf16x8 pa3) {
#define TRRD(dst, off) asm volatile("ds_read_b64_tr_b16 %0, %1 offset:%2" : "=&v"(dst) : "v"(vb), "i"(off) : "memory")
#define VSET(S, d0) do { constexpr int b_ = (d0) * 512; TRRD(S##l0, b_); TRRD(S##h0, b_ + 2048); TRRD(S##l1, b_ + 4096); TRRD(S##h1, b_ + 6144); \
        TRRD(S##l2, b_ + 8192); TRRD(S##h2, b_ + 10240); TRRD(S##l3, b_ + 12288); TRRD(S##h3, b_ + 14336); } while (0)
#define VMMA(S, d0) do { \
        o[d0] = __builtin_amdgcn_mfma_f32_32x32x16_bf16(pa0, (bf16x8){S##l0[0], S##l0[1], S##l0[2], S##l0[3], S##h0[0], S##h0[1], S##h0[2], S##h0[3]}, o[d0], 0, 0, 0); \
        o[d0] = __builtin_amdgcn_mfma_f32_32x32x16_bf16(pa1, (bf16x8){S##l1[0], S##l1[1], S##l1[2], S##l1[3], S##h1[0], S##h1[1], S##h1[2], S##h1[3]}, o[d0], 0, 0, 0); \
        o[d0] = __builtin_amdgcn_mfma_f32_32x32x16_bf16(pa2, (bf16x8){S##l2[0], S##l2[1], S##l2[2], S##l2[3], S##h2[0], S##h2[1], S##h2[2], S##h2[3]}, o[d0], 0, 0, 0); \
        o[d0] = __builtin_amdgcn_mfma_f32_32x32x16_bf16(pa3, (bf16x8){S##l3[0], S##l3[1], S##l3[2], S##l3[3], S##h3[0], S##h3[1], S##h3[2], S##h3[3]}, o[d0], 0, 0, 0); } while (0)
#define LWAIT(n) do { asm volatile("s_waitcnt lgkmcnt(" #n ")" ::: "memory"); SBAR(); } while (0)
    s16x4 Al0, Al1, Al2, Al3, Ah0, Ah1, Ah2, Ah3, Bl0, Bl1, Bl2, Bl3, Bh0, Bh1, Bh2, Bh3;
    VSET(A, 0);
    VSET(B, 1); LWAIT(8); VMMA(A, 0); SBAR();
    VSET(A, 2); LWAIT(8); VMMA(B, 1); SBAR();
    VSET(B, 3); LWAIT(8); VMMA(A, 2); SBAR();
    LWAIT(0); VMMA(B, 3);
#undef LWAIT
#undef VMMA
#undef VSET
#undef TRRD
}

#ifndef ATT_SPLIT
#define ATT_SPLIT 0
#endif
constexpr int UNIT_ROWS = ATT_SPLIT ? 128 : 256, QB_PER_HEAD = SEQ / UNIT_ROWS, NU_B = 256 + 6 * QB_PER_HEAD;
static_assert(NUNITS == 256 + 12 * QB_PER_HEAD, "unit table");
__device__ __forceinline__ void pv_tile_half(f32x16* o, unsigned vb, bf16x8 pa0, bf16x8 pa1) {
#define TRRD(dst, off) asm volatile("ds_read_b64_tr_b16 %0, %1 offset:%2" : "=&v"(dst) : "v"(vb), "i"(off) : "memory")
#define PV_D0H(d0) do { s16x4 l0, l1, h0, h1; constexpr int b_ = (d0) * 512; \
        TRRD(l0, b_); TRRD(h0, b_ + 2048); TRRD(l1, b_ + 4096); TRRD(h1, b_ + 6144); \
        asm volatile("s_waitcnt lgkmcnt(0)" ::: "memory"); SBAR(); \
        o[d0] = __builtin_amdgcn_mfma_f32_32x32x16_bf16(pa0, (bf16x8){l0[0], l0[1], l0[2], l0[3], h0[0], h0[1], h0[2], h0[3]}, o[d0], 0, 0, 0); \
        o[d0] = __builtin_amdgcn_mfma_f32_32x32x16_bf16(pa1, (bf16x8){l1[0], l1[1], l1[2], l1[3], h1[0], h1[1], h1[2], h1[3]}, o[d0], 0, 0, 0); } while (0)
    PV_D0H(0); PV_D0H(1); PV_D0H(2); PV_D0H(3);
#undef PV_D0H
#undef TRRD
}

#ifndef FORCE_SAFE
#define FORCE_SAFE 0
#endif
template <int MODE, int VARI>
__device__ __forceinline__ void attn_unit(LAS unsigned char* lds, const int tid, const AttnP& a, float c2, float lam, const float* subln, float outscale, float fox_u, const bool fast) {
    constexpr bool SPLIT = (MODE != 0) && (ATT_SPLIT != 0);
    constexpr bool WIDE = (MODE != 0) && !SPLIT;
    constexpr int DK = MODE == 0 ? 64 : (MODE == 1 ? 128 : 192), KW = MODE == 2 ? 192 : 128;
    constexpr int VBYTES = 16384, KBYTES = 64 * KW * 2, OFF_K = 3 * VBYTES, OFF_B = OFF_K + 3 * KBYTES, OFF_W = OFF_B + 8 * 3 * 256;
    constexpr int NDMA = KW / 64 + 2 + (MODE == 1 ? 1 : 0);
    const int wid = __builtin_amdgcn_readfirstlane(tid >> 6), lane = tid & 63, r32 = lane & 31, hi = lane >> 5, grp = wid >> 2;
    const int wrow = (WIDE ? wid : (wid & 3)) * 32, kcoff = MODE == 0 ? grp * 64 : 0, khalf = SPLIT ? grp : 0;
    const int NT = (a.P0 + (WIDE ? 256 : 128)) >> 6;
    const int qpos0 = a.P0 + wrow, pos = qpos0 + r32;
    LAS unsigned char* V_lds = lds; LAS unsigned char* K_lds = lds + OFF_K; LAS float* B_lds = (LAS float*)(lds + OFF_B);
    LAS float* wsc = (LAS float*)(lds + OFF_W) + wid * 64; LAS float* li_l = wsc; LAS float* al_l = wsc + 32;
    bf16x8 qr[DK / 16];
    { const bf16_t* qp = a.Q + (size_t)pos * a.qpitch + kcoff + hi * 8;
#pragma unroll
      for (int d0 = 0; d0 < DK / 16; ++d0) qr[d0] = *(const bf16x8*)(qp + d0 * 16); }
    float cP0 = 0.f, ct2 = 0.f; if (MODE == 1) { cP0 = a.cum[(size_t)a.P0 * 8]; ct2 = a.cum[(size_t)pos * 8] - cP0; }
    float sb = 0.f;
#define A_ISSUE_V(t, bf) do { const int k0_ = (t) * 64; int tt_ = tid; asm volatile("" : "+v"(tt_)); const int ln_ = tt_ & 63; \
        _Pragma("unroll") for (int i_ = 0; i_ < 2; ++i_) { const int ch_ = wid + 8 * i_, b_ = ch_ * 1024 + ln_ * 16, sub_ = b_ >> 9, wi_ = (b_ & 511) >> 1; \
            const int kk_ = (sub_ >> 2) * 8 + (wi_ >> 5), c_ = (sub_ & 3) * 32 + (wi_ & 31), k_ = (kk_ & ~0xC) | ((kk_ & 4) << 1) | ((kk_ & 8) >> 1); \
            __builtin_amdgcn_global_load_lds((const unsigned*)(a.V + (size_t)(k0_ + k_) * a.vpitch + c_), (LAS unsigned*)(V_lds + (bf) * VBYTES + ch_ * 1024), 16, 0, 0); } } while (0)
#define A_ISSUE_K(t, bf) do { const int k0_ = (t) * 64; int tt_ = tid; asm volatile("" : "+v"(tt_)); const int ln_ = tt_ & 63; \
        _Pragma("unroll") for (int i_ = 0; i_ < KW / 64; ++i_) { const int ch_ = wid + 8 * i_, b_ = ch_ * 1024 + ln_ * 16, krow_ = b_ / (KW * 2), cs_ = (b_ % (KW * 2)) >> 4; \
            const int kcc_ = cs_ ^ (kswz<KW>(krow_) >> 4); \
            const bf16_t* p_ = (MODE == 2 && kcc_ >= 8) ? a.K1 + (size_t)(k0_ + krow_) * a.k1pitch + (kcc_ - 8) * 8 : a.K0 + (size_t)(k0_ + krow_) * a.k0pitch + kcc_ * 8; \
            __builtin_amdgcn_global_load_lds((const unsigned*)p_, (LAS unsigned*)(K_lds + (bf) * KBYTES + ch_ * 1024), 16, 0, 0); } } while (0)
    const unsigned krb = (unsigned)(uintptr_t)K_lds + r32 * (KW * 2), kxm = kswz<KW>(r32), kcb = kcoff * 2 + hi * 16;
    const unsigned vb0 = (unsigned)(uintptr_t)V_lds + v_rd_base(lane);

    float m_reg = -1e30f, l_reg = 0.f; f32x16 o[4];
#pragma unroll
    for (int d = 0; d < 4; ++d)
#pragma unroll
        for (int r = 0; r < 16; ++r) o[d][r] = 0.f;

    int t_lo = 0;
    if (MODE == 1) {
        const float thr = 150.f + 2.f * fox_u;
        const int ntq = a.P0 >> 6;
        const int pred = (tid < ntq) && (a.cum[(size_t)(tid * 64 + 63) * 8] - cP0 > thr);
        t_lo = __syncthreads_count(pred);
    }
    if (fast && !FORCE_SAFE) {
      f32x2 ls = {0.f, 0.f};
#define QK_TILE(P0_, P1_, SLOT) do { \
        _Pragma("unroll") for (int r = 0; r < 16; ++r) { P0_[r] = 0.f; P1_[r] = 0.f; } \
        _Pragma("unroll") for (int d0 = 0; d0 < DK / 16; ++d0) { const unsigned ad = krb + ((kcb + 32 * d0) ^ kxm) + (SLOT) * KBYTES + khalf * (32 * KW * 2); \
            P0_ = __builtin_amdgcn_mfma_f32_32x32x16_bf16(*(const LAS bf16x8*)(uintptr_t)ad, qr[d0], P0_, 0, 0, 0); \
            if (!SPLIT) P1_ = __builtin_amdgcn_mfma_f32_32x32x16_bf16(*(const LAS bf16x8*)(uintptr_t)(ad + 32 * KW * 2), qr[d0], P1_, 0, 0, 0); } } while (0)
#define PK4F(P, B_, OUT) do { unsigned a0 = cvtpk(P[B_ + 0], P[B_ + 1]), a1 = cvtpk(P[B_ + 2], P[B_ + 3]); \
        unsigned b0 = cvtpk(P[B_ + 4], P[B_ + 5]), b1 = cvtpk(P[B_ + 6], P[B_ + 7]); \
        auto r0 = __builtin_amdgcn_permlane32_swap(a0, b0, false, false); auto r1 = __builtin_amdgcn_permlane32_swap(a1, b1, false, false); \
        u32x4 w = {r0[0], r1[0], r0[1], r1[1]}; OUT = *reinterpret_cast<bf16x8*>(&w); } while (0)
#define SM_GROUP_ON(P_, J_, KO_, MASKED) do { \
        if (MODE == 1) { const f32x4 cb = *(const LAS f32x4*)(Bw_lds + i0 * 64 + (KO_) + 8 * (J_) + 4 * hi); \
            _Pragma("unroll") for (int e = 0; e < 4; ++e) P_[4 * (J_) + e] = fmaf(P_[4 * (J_) + e], c2, ctp - cb[e]); } \
        else { _Pragma("unroll") for (int e = 0; e < 4; ++e) P_[4 * (J_) + e] *= c2; } \
        if (MASKED) { _Pragma("unroll") for (int e = 0; e < 4; ++e) { if (dq - (e + 8 * (J_) + (KO_)) < 0) P_[4 * (J_) + e] = -__builtin_inff(); } } \
        _Pragma("unroll") for (int e = 0; e < 4; ++e) { P_[4 * (J_) + e] = __builtin_amdgcn_exp2f(P_[4 * (J_) + e]); ls[e & 1] += P_[4 * (J_) + e]; } } while (0)
#define SM_SLICE(S_, MASKED) do { \
        if (MODE == 0) { if ((S_) < 2) { SM_GROUP_ON(pA0, 2 * (S_), 0, MASKED); SM_GROUP_ON(pA0, 2 * (S_) + 1, 0, MASKED); } \
                         else { SM_GROUP_ON(pA1, 2 * (S_) - 4, 32, MASKED); SM_GROUP_ON(pA1, 2 * (S_) - 3, 32, MASKED); } \
                         if ((S_) == 0) PK4F(pA0, 0, pa0); else if ((S_) == 1) PK4F(pA0, 8, pa1); else if ((S_) == 2) PK4F(pA1, 0, pa2); else PK4F(pA1, 8, pa3); } \
        else if (WIDE) { if ((S_) < 4) SM_GROUP_ON(pA0, (S_), 0, MASKED); else if ((S_) < 8) SM_GROUP_ON(pA1, (S_) - 4, 32, MASKED); \
                         if ((S_) == 1) PK4F(pA0, 0, pa0); else if ((S_) == 3) PK4F(pA0, 8, pa1); else if ((S_) == 5) PK4F(pA1, 0, pa2); else if ((S_) == 7) PK4F(pA1, 8, pa3); } \
        else if (MODE == 1) { if ((S_) < 4) SM_GROUP_ON(pA0, (S_), 32 * khalf, MASKED); else if ((S_) == 5) PK4F(pA0, 0, pa0); else if ((S_) == 6) PK4F(pA0, 8, pa1); } \
        else { if ((S_) < 8 && !((S_) & 1)) SM_GROUP_ON(pA0, (S_) >> 1, 32 * khalf, MASKED); else if ((S_) == 8) PK4F(pA0, 0, pa0); else if ((S_) == 9) PK4F(pA0, 8, pa1); } } while (0)
#define FAST_TILE(MASKED) do { f32x16 pB0, pB1; bf16x8 pa0, pa1, pa2, pa3; \
        _Pragma("unroll") for (int r = 0; r < 16; ++r) { pB0[r] = 0.f; pB1[r] = 0.f; } \
        _Pragma("unroll") for (int s = 0; s < DK / 16; ++s) { bf16x8 kfa, kfb; SBAR(); \
            { const unsigned ad = krb + ((kcb + 32 * s) ^ kxm) + i1 * KBYTES + khalf * (32 * KW * 2);     \
              kfa = *(const LAS bf16x8*)(uintptr_t)ad; if (!SPLIT) kfb = *(const LAS bf16x8*)(uintptr_t)(ad + 32 * KW * 2); } \
            SM_SLICE(s, MASKED); \
            pB0 = __builtin_amdgcn_mfma_f32_32x32x16_bf16(kfa, qr[s], pB0, 0, 0, 0);     \
            if (!SPLIT) pB1 = __builtin_amdgcn_mfma_f32_32x32x16_bf16(kfb, qr[s], pB1, 0, 0, 0); } \
        SBAR(); \
        if (SPLIT) pv_tile_half(o, vb0 + i0 * VBYTES + khalf * 8192, pa0, pa1); else pv_tile(o, vb0 + i0 * VBYTES, pa0, pa1, pa2, pa3); \
        pA0 = pB0; if (!SPLIT) pA1 = pB1; } while (0)
      unsigned voff[2], koff[KW / 64], kstp[KW / 64], boff = 0; int vt = t_lo, kt = t_lo;
      { int tt_ = tid; asm volatile("" : "+v"(tt_)); const int ln_ = tt_ & 63;
#pragma unroll
        for (int i_ = 0; i_ < 2; ++i_) { const int ch_ = wid + 8 * i_, b_ = ch_ * 1024 + ln_ * 16, sub_ = b_ >> 9, wi_ = (b_ & 511) >> 1;
            const int kk_ = (sub_ >> 2) * 8 + (wi_ >> 5), c_ = (sub_ & 3) * 32 + (wi_ & 31), k_ = (kk_ & ~0xC) | ((kk_ & 4) << 1) | ((kk_ & 8) >> 1);
            voff[i_] = (unsigned)(((t_lo * 64 + k_) * a.vpitch + c_) * 2); }
#pragma unroll
        for (int i_ = 0; i_ < KW / 64; ++i_) { const int ch_ = wid + 8 * i_, b_ = ch_ * 1024 + ln_ * 16, krow_ = b_ / (KW * 2), cs_ = (b_ % (KW * 2)) >> 4;
            const int kcc_ = cs_ ^ (kswz<KW>(krow_) >> 4);
            if (MODE == 2 && kcc_ >= 8) { koff[i_] = (unsigned)((const char*)a.K1 - (const char*)a.K0) + (unsigned)(((t_lo * 64 + krow_) * a.k1pitch + (kcc_ - 8) * 8) * 2); kstp[i_] = (unsigned)(64 * a.k1pitch * 2); }
            else { koff[i_] = (unsigned)(((t_lo * 64 + krow_) * a.k0pitch + kcc_ * 8) * 2); kstp[i_] = (unsigned)(64 * a.k0pitch * 2); } }
        if (MODE == 1) boff = (unsigned)((t_lo * 64 + ln_) * 32); }
#define DMA_V(T_, SLOT) do { \
        _Pragma("unroll") for (int i_ = 0; i_ < 2; ++i_) \
            __builtin_amdgcn_global_load_lds((const unsigned*)((const char*)a.V + voff[i_]), (LAS unsigned*)(V_lds + (SLOT) * VBYTES + (wid + 8 * i_) * 1024), 16, 0, 0); \
        if (MODE == 1) __builtin_amdgcn_global_load_lds((const unsigned*)((const char*)a.cum + boff), (LAS unsigned*)(Bw_lds + (SLOT) * 64), 4, 0, 0); \
        if (vt < NT - 1) { ++vt; _Pragma("unroll") for (int i_ = 0; i_ < 2; ++i_) voff[i_] += (unsigned)(64 * a.vpitch * 2); if (MODE == 1) boff += 64 * 32; } } while (0)
#define DMA_K(T_, SLOT) do { \
        _Pragma("unroll") for (int i_ = 0; i_ < KW / 64; ++i_) \
            __builtin_amdgcn_global_load_lds((const unsigned*)((const char*)a.K0 + koff[i_]), (LAS unsigned*)(K_lds + (SLOT) * KBYTES + (wid + 8 * i_) * 1024), 16, 0, 0); \
        if (kt < NT - 1) { ++kt; _Pragma("unroll") for (int i_ = 0; i_ < KW / 64; ++i_) koff[i_] += kstp[i_]; } } while (0)
      LAS float* Bw_lds = B_lds + wid * 192;
      const float ctp = ct2 + cP0;
      int i0 = t_lo % 3, i1 = (t_lo + 1) % 3, i2 = (t_lo + 2) % 3;
      DMA_K(t_lo, i0); DMA_V(t_lo, i0); DMA_K(t_lo + 1, i1); DMA_V(t_lo + 1, i1); DMA_K(t_lo + 2, i2);
      asm volatile("s_waitcnt vmcnt(0)" ::: "memory"); __builtin_amdgcn_s_barrier(); asm volatile("" ::: "memory");
      f32x16 pA0, pA1;
      QK_TILE(pA0, pA1, i0);
      asm volatile("s_waitcnt lgkmcnt(0)" ::: "memory"); __builtin_amdgcn_s_barrier(); asm volatile("" ::: "memory");
      const int t_nm = a.P0 >> 6;
#define FAST_ITER(MASKED) do { \
        if (!(VARI & 16)) { DMA_K(t + 3, i0);         \
        DMA_V(t + 2, i2); }                           \
        const int dq = pos - t * 64 - 4 * hi; (void)dq; \
        FAST_TILE(MASKED); \
        if (!(VARI & 8)) { asm volatile("s_waitcnt vmcnt(%0)" :: "n"(NDMA) : "memory");     \
        __builtin_amdgcn_s_barrier(); } asm volatile("" ::: "memory"); \
        { const int r_ = i0; i0 = i1; i1 = i2; i2 = r_; } } while (0)
      int t = t_lo;
      for (; t < t_nm; ++t) FAST_ITER(false);
      for (; t < NT; ++t) FAST_ITER(true);
#undef FAST_ITER
#undef DMA_K
#undef DMA_V
#undef FAST_TILE
#undef SM_SLICE
#undef SM_GROUP_ON
#undef PK4F
#undef QK_TILE
      { float ps = ls[0] + ls[1];
        auto rr = __builtin_amdgcn_permlane32_swap(__float_as_uint(ps), __float_as_uint(ps), false, false);
        l_reg = __uint_as_float(rr[0]) + __uint_as_float(rr[1]); }
    } else {
    int tl_ = lane; asm volatile("" : "+v"(tl_));
    const int r32_s = tl_ & 31, hi_s = tl_ >> 5, pos_s = qpos0 + r32_s;
    const unsigned krb_s = (unsigned)(uintptr_t)K_lds + r32_s * (KW * 2), kxm_s = kswz<KW>(r32_s), kcb_s = kcoff * 2 + hi_s * 16;
    const unsigned vb0_s = (unsigned)(uintptr_t)V_lds + v_rd_base(tl_);
    const bool active = !SPLIT || wid < 4;
#define S_ISSUE(t, bf) do { A_ISSUE_V(t, bf); A_ISSUE_K(t, bf); if (MODE == 1) { int tt_ = tid; asm volatile("" : "+v"(tt_)); if (tt_ < 64) sb = cP0 - a.cum[(size_t)((t) * 64 + tt_) * 8]; } } while (0)
#define S_WRITE(bf) do { if (MODE == 1) { int tt_ = tid; asm volatile("" : "+v"(tt_)); if (tt_ < 64) B_lds[(bf) * 64 + tt_] = sb; } } while (0)
    S_ISSUE(t_lo, t_lo & 1); S_WRITE(t_lo & 1);
    __syncthreads();
    for (int t = t_lo; t < NT; ++t) {
        const int bf = t & 1;
        if (t + 1 < NT) S_ISSUE(t + 1, bf ^ 1);
        if (active) {
        f32x16 p0, p1;
#pragma unroll
        for (int r = 0; r < 16; ++r) { p0[r] = 0.f; p1[r] = 0.f; }
#pragma unroll
        for (int d0 = 0; d0 < DK / 16; ++d0) {
            const unsigned ad = krb_s + ((kcb_s + 32 * d0) ^ kxm_s) + bf * KBYTES;
            const bf16x8 b0 = *(const LAS bf16x8*)(uintptr_t)ad;
            const bf16x8 b1 = *(const LAS bf16x8*)(uintptr_t)(ad + 32 * KW * 2);
            p0 = __builtin_amdgcn_mfma_f32_32x32x16_bf16(b0, qr[d0], p0, 0, 0, 0);
            p1 = __builtin_amdgcn_mfma_f32_32x32x16_bf16(b1, qr[d0], p1, 0, 0, 0);
            if ((d0 & 3) == 3) SBAR();
        }
        if (MODE == 1) {
#pragma unroll
            for (int j = 0; j < 4; ++j) {
                const f32x4 c0 = *(const LAS f32x4*)(B_lds + bf * 64 + 8 * j + 4 * hi_s), c1 = *(const LAS f32x4*)(B_lds + bf * 64 + 32 + 8 * j + 4 * hi_s);
#pragma unroll
                for (int e = 0; e < 4; ++e) { p0[4 * j + e] = fmaf(p0[4 * j + e], c2, ct2 + c0[e]); p1[4 * j + e] = fmaf(p1[4 * j + e], c2, ct2 + c1[e]); }
            }
        } else {
#pragma unroll
            for (int r = 0; r < 16; ++r) { p0[r] *= c2; p1[r] *= c2; }
        }
        if (t * 64 + 63 > qpos0) {
            const int dq = pos_s - t * 64 - 4 * hi_s; const float NEG = -__builtin_inff();
#pragma unroll
            for (int r = 0; r < 16; ++r) { const int cc = (r & 3) + 8 * (r >> 2); if (dq - cc < 0) p0[r] = NEG; if (dq - cc - 32 < 0) p1[r] = NEG; }
        }
        float pmax = p0[0];
#pragma unroll
        for (int r = 1; r < 16; ++r) pmax = fmaxf(pmax, p0[r]);
#pragma unroll
        for (int r = 0; r < 16; ++r) pmax = fmaxf(pmax, p1[r]);
        { auto rr = __builtin_amdgcn_permlane32_swap(__float_as_uint(pmax), __float_as_uint(pmax), false, false);
          pmax = fmaxf(__uint_as_float(rr[0]), __uint_as_float(rr[1])); }
        float mn, alpha;
        if (__all(pmax - m_reg <= 8.0f)) { mn = m_reg; alpha = 1.f; }
        else { mn = fmaxf(m_reg, pmax); alpha = __builtin_amdgcn_exp2f(m_reg - mn); m_reg = mn; }
        float ps = 0.f;
#pragma unroll
        for (int r = 0; r < 16; ++r) { p0[r] = __builtin_amdgcn_exp2f(p0[r] - mn); p1[r] = __builtin_amdgcn_exp2f(p1[r] - mn); }
#pragma unroll
        for (int r = 0; r < 16; ++r) ps += p0[r] + p1[r];
        { auto rr = __builtin_amdgcn_permlane32_swap(__float_as_uint(ps), __float_as_uint(ps), false, false);
          ps = __uint_as_float(rr[0]) + __uint_as_float(rr[1]); }
        l_reg = l_reg * alpha + ps;
        bf16x8 pa0, pa1, pa2, pa3;
#define PK4(P, B_, OUT) do { unsigned a0 = cvtpk(P[B_ + 0], P[B_ + 1]), a1 = cvtpk(P[B_ + 2], P[B_ + 3]); \
        unsigned b0 = cvtpk(P[B_ + 4], P[B_ + 5]), b1 = cvtpk(P[B_ + 6], P[B_ + 7]); \
        auto r0 = __builtin_amdgcn_permlane32_swap(a0, b0, false, false); auto r1 = __builtin_amdgcn_permlane32_swap(a1, b1, false, false); \
        u32x4 w = {r0[0], r1[0], r0[1], r1[1]}; OUT = *reinterpret_cast<bf16x8*>(&w); } while (0)
        PK4(p0, 0, pa0); PK4(p0, 8, pa1); PK4(p1, 0, pa2); PK4(p1, 8, pa3);
#undef PK4
        if (__any(alpha < 1.f)) {
            if (hi_s == 0) al_l[r32_s] = alpha;
            asm volatile("s_waitcnt lgkmcnt(0)" ::: "memory");
#pragma unroll
            for (int r = 0; r < 16; ++r) { const float al = al_l[crow(r, hi_s)];
#pragma unroll
                for (int d = 0; d < 4; ++d) o[d][r] *= al; }
        }
        pv_tile(o, vb0_s + bf * VBYTES, pa0, pa1, pa2, pa3);
        }
        if (t + 1 < NT) S_WRITE(bf ^ 1);
        __syncthreads();
    }
#undef S_ISSUE
#undef S_WRITE
    }
#undef A_ISSUE_V
#undef A_ISSUE_K
    asm volatile("s_waitcnt vmcnt(0)" ::: "memory");
    __syncthreads();
    LAS float* X = (LAS float*)lds + (wid & 3) * 4096 + lane;
    LAS float* LX = (LAS float*)(lds + 65536) + (wid & 3) * 32;
    if (MODE == 0) {
        if (hi == 0) li_l[r32] = l_reg;
        asm volatile("s_waitcnt lgkmcnt(0)" ::: "memory");
#pragma unroll
        for (int r = 0; r < 16; ++r) { const float rl = __builtin_amdgcn_rcpf(li_l[crow(r, hi)]);
#pragma unroll
            for (int d = 0; d < 4; ++d) o[d][r] *= rl; }
        if (wid >= 4) {
#pragma unroll
            for (int d = 0; d < 4; ++d)
#pragma unroll
                for (int r = 0; r < 16; ++r) X[(d * 16 + r) * 64] = o[d][r];
        }
        __syncthreads();
        if (wid < 4) {
            const float g0 = subln[r32], g1 = subln[32 + r32], g2 = subln[64 + r32], g3 = subln[96 + r32];
#pragma unroll
            for (int r = 0; r < 16; ++r) {
                float v[4]; float ss = 0.f;
#pragma unroll
                for (int d = 0; d < 4; ++d) { v[d] = o[d][r] - lam * X[(d * 16 + r) * 64]; ss += v[d] * v[d]; }
                ss += __shfl_xor(ss, 1); ss += __shfl_xor(ss, 2); ss += __shfl_xor(ss, 4); ss += __shfl_xor(ss, 8); ss += __shfl_xor(ss, 16);
                const float rs = rsqrtf(ss * (1.0f / 128.0f) + RMS_EPS) * outscale;
                o[0][r] = v[0] * rs * g0; o[1][r] = v[1] * rs * g1; o[2][r] = v[2] * rs * g2; o[3][r] = v[3] * rs * g3;
            }
        }
    } else if (WIDE) {
        if (hi == 0) li_l[r32] = l_reg;
        asm volatile("s_waitcnt lgkmcnt(0)" ::: "memory");
#pragma unroll
        for (int r = 0; r < 16; ++r) { const float rl = __builtin_amdgcn_rcpf(li_l[crow(r, hi)]);
#pragma unroll
            for (int d = 0; d < 4; ++d) o[d][r] *= rl; }
    } else {
        if (wid >= 4) {
#pragma unroll
            for (int d = 0; d < 4; ++d)
#pragma unroll
                for (int r = 0; r < 16; ++r) X[(d * 16 + r) * 64] = o[d][r];
            if (hi == 0) LX[r32] = l_reg;
        }
        __syncthreads();
        if (wid < 4) {
            if (hi == 0) li_l[r32] = l_reg + LX[r32];
            asm volatile("s_waitcnt lgkmcnt(0)" ::: "memory");
#pragma unroll
            for (int r = 0; r < 16; ++r) { const float rl = __builtin_amdgcn_rcpf(li_l[crow(r, hi)]);
#pragma unroll
                for (int d = 0; d < 4; ++d) o[d][r] = (o[d][r] + X[(d * 16 + r) * 64]) * rl; }
        }
    }
    if (WIDE || wid < 4) {
        bf16_t* Ow = a.O + (size_t)qpos0 * 2048;
#pragma unroll
        for (int r = 0; r < 16; ++r) { const int orow = crow(r, hi);
#pragma unroll
            for (int d = 0; d < 4; ++d) { const float v = o[d][r]; const float vn = __shfl_xor(v, 1);
                if ((r32 & 1) == 0) *(unsigned*)(Ow + (size_t)orow * 2048 + d * 32 + r32) = cvtpk(v, vn); } }
    }
    __syncthreads();
}

#ifndef DUP
#define DUP 0
#endif
#ifndef AV
#define AV 0
#endif
__device__ __forceinline__ void tr_drain(ArgsP a, LAS unsigned char* lds, int tid, int* counter, int l, int late, int max_chunks) {
    LAS int* slot = (LAS int*)(lds + LDS_BYTES - 64);
    const int lane = tid & 63, wave = __builtin_amdgcn_readfirstlane(tid >> 6), n_items = late ? TR_N_LATE : TR_N_EARLY, n_chunks = (n_items + TR_CHUNK - 1) / TR_CHUNK;
    LAS float* scr = (LAS float*)(lds + wave * 8704);
    for (int n = 0; n < max_chunks; ++n) {
        if (tid == 0) *slot = atomicAdd(counter, 1);
        __syncthreads();
        const int ch = *slot;
        __syncthreads();
        if (ch >= n_chunks) break;
#pragma unroll 1
        for (int j = 0; j < 4; ++j) { const int i = ch * TR_CHUNK + wave * 4 + j; if (i < n_items) tr_dispatch(a, l, late ? tr_late_item(i) : tr_early_item(i), scr, lane); }
    }
}
template <int VARI>
__device__ __forceinline__ void attention_phase(ArgsP a, int l, LAS unsigned char* lds, int cslot) {
    unsigned char* ws = a->ws;
    const bf16_t* PROJ = (const bf16_t*)(ws + WS_PROJ); const bf16_t* QC = (const bf16_t*)(ws + WS_QC); const bf16_t* KVC = (const bf16_t*)(ws + WS_KVC);
    bf16_t* MIX = (bf16_t*)(ws + (VARI == 0 ? WS_MIX : WS_END));
    const int* table = (const int*)(ws + WS_TABLE); int* counter = (int*)(ws + WS_CNT) + 4 * (l + cslot);
    LAS int* slot = (LAS int*)(lds + LDS_BYTES - 64);
    const float lam = ((const float*)(ws + WS_LAM))[l], fox_u = ((const float*)(ws + WS_LAM))[8 + l], ub_a = ((const float*)(ws + WS_LAM))[12 + l], ub_c = ((const float*)(ws + WS_LAM))[16 + l];
    const float linit = 0.8f - 0.6f * expf(-0.3f * (float)l);
    int tid_ = threadIdx.x; asm volatile("" : "+v"(tid_)); const int tid = tid_;
    for (;;) {
        if (tid == 0) *slot = atomicAdd(counter, 1);
        __syncthreads();
        const int idx = *slot;
        __syncthreads();
        if (idx >= NUNITS) break;
        const int id = table[idx];
        int tu_ = tid; asm volatile("" : "+v"(tu_)); const int tu = tu_;
        AttnP p{};
#ifndef ATM
#define ATM 7
#endif
        if (id < 256 && (ATM & 1) && (VARI == 0 || (VARI & 1))) {
            const int h = id >> 6, qb = id & 63;
            p.Q = PROJ + C_DQ + h * 128; p.qpitch = NINP; p.K0 = PROJ + C_DK + h * 128; p.k0pitch = NINP; p.K1 = p.K0; p.k1pitch = NINP;
            p.V = PROJ + C_DV + h * 128; p.vpitch = NINP; p.cum = nullptr; p.O = MIX + h * 128; p.P0 = qb * 128; p.rows = 128;
            attn_unit<0, VARI>(lds, tu, p, 0.125f * LOG2E, lam, a->in[I_SUBLN] + l * 128, 1.0f - linit, 0.f, ub_a < 60.f);
        } else if (id >= 256 && id < NU_B && (ATM & 2) && (VARI == 0 || (VARI & 2))) {
            const int h = (id - 256) / QB_PER_HEAD, qb = (id - 256) % QB_PER_HEAD;
            p.Q = PROJ + C_FQ + h * 128; p.qpitch = NINP; p.K0 = PROJ + C_FK + h * 128; p.k0pitch = NINP; p.K1 = p.K0; p.k1pitch = NINP;
            p.V = PROJ + C_FV + h * 128; p.vpitch = NINP; p.cum = (const float*)(ws + WS_CUM) + h; p.O = MIX + 512 + h * 128; p.P0 = qb * UNIT_ROWS; p.rows = UNIT_ROWS;
            attn_unit<1, VARI>(lds, tu, p, 0.08838834764831845f * LOG2E, 0.f, nullptr, 1.f, fox_u, fox_u < 60.f);
        } else if (id >= NU_B && (ATM & 4) && (VARI == 0 || (VARI & 4))) {
            const int h = (id - NU_B) / QB_PER_HEAD, qb = (id - NU_B) % QB_PER_HEAD;
            p.Q = QC + h * 192; p.qpitch = NQUPP; p.K0 = PROJ + C_KR; p.k0pitch = NINP; p.K1 = KVC + h * 256; p.k1pitch = NKVUP;
            p.V = KVC + h * 256 + 128; p.vpitch = NKVUP; p.cum = nullptr; p.O = MIX + 1280 + h * 128; p.P0 = qb * UNIT_ROWS; p.rows = UNIT_ROWS;
            attn_unit<2, VARI>(lds, tu, p, 0.07216878364870322f * LOG2E, 0.f, nullptr, 1.f, 0.f, ub_c < 60.f);
        }
    }    if (VARI == 0) {
        int* cnt = (int*)(ws + WS_CNT);
        tr_drain(a, lds, tid, cnt + 24 + 2 * l, l, 1, 1 << 20);
        if (l == 0) tr_drain(a, lds, tid, cnt + 25, 1, 0, 1 << 20);
    }
}

#ifndef PHM
#define PHM 0x1ff
#endif
constexpr int PH_PER_LAYER = 8, N_PHASES = 1 + 2 * PH_PER_LAYER;
__global__ void __launch_bounds__(512, 2) fwd_kernel(Args a_unused) {
    extern __shared__ __attribute__((aligned(16))) unsigned char lds_raw[];
    LAS unsigned char* lds = (LAS unsigned char*)lds_raw;
    cg::grid_group grid = cg::this_grid();
    ArgsP a0 = (ArgsP)__builtin_amdgcn_kernarg_segment_ptr();
    const int G = gridDim.x, ph_lo = a0->ph_lo, ph_hi = a0->ph_hi;
    volatile LAS unsigned* bst = (volatile LAS unsigned*)(lds + 131072 + 128);
    if (threadIdx.x == 0) { bst[0] = 0u; bst[1] = 0u; }
    __syncthreads();
    (void)xcd_barrier_post((unsigned*)(a0->ws + WS_BAR), bst);
    int ph = ph_lo;
    if (ph_hi > 1000) grid.sync();
    if (ph == 0) {
        ArgsP ap = a0; asm volatile("" : "+s"(ap)); if (PHM & 1) prologue(ap, lds);
        ph = 1;
        if (ph < ph_hi) { XcdBarrier b2; b2.bar = (unsigned*)(ap->ws + WS_BAR); b2.x = xb_xcc_id(); b2.st = bst; xcd_barrier(b2); }
    }
    for (; ph < ph_hi; ++ph) {
        ArgsP a = a0; asm volatile("" : "+s"(a));
        unsigned char* ws = a->ws;
        bf16_t* XB = (bf16_t*)(ws + WS_XB); float* XF = (float*)(ws + WS_XF); bf16_t* MIX = (bf16_t*)(ws + WS_MIX); bf16_t* PROJ = (bf16_t*)(ws + WS_PROJ);
        bf16_t* QC = (bf16_t*)(ws + WS_QC); bf16_t* KVC = (bf16_t*)(ws + WS_KVC); bf16_t* HB = (bf16_t*)(ws + WS_H); float* SSQ = (float*)(ws + WS_SSQ);
                const int l = (ph - 1) / PH_PER_LAYER, sp = (ph - 1) % PH_PER_LAYER;
        int tid_ = threadIdx.x; asm volatile("" : "+v"(tid_));
        const int lane = tid_ & 63, wave = __builtin_amdgcn_readfirstlane(tid_ >> 6), gw = blockIdx.x * 8 + wave, NGW = G * 8;
        if (sp == 0 && (PHM & 2)) {
            pg8::Gemm g{XB, (const bf16_t*)(ws + WS_WIN + l * SZ_WIN), SEQ, NINP, DM, DM}; pg8::StaticOrder S; S.init(SEQ, NINP, G, (int)blockIdx.x);
            pg8::EpiScaleBf16<false> E{PROJ, NINP, SSQ + (2 * l) * SEQ};
            pg8::gemm_phase<pg8::EpiScaleBf16<false>, pg8::StaticOrder, true, true>(lds, g, S, E);
            if ((int)blockIdx.x >= (SEQ / 256) * (NINP / 256) - 2 * G) tr_drain(a, lds, tid_, (int*)(ws + WS_CNT) + 24 + 2 * l, l, 1, 1);
        } else if (sp == 1 && (PHM & 4)) {
            for (int m = gw; m < SEQ; m += NGW) post_proj_row(a, l, m, lane);
        } else if (sp == 2 && (PHM & 8)) {
            { const int cb_ = (G >= 166) ? 160 : 0;
              if ((int)blockIdx.x >= cb_ && (int)blockIdx.x < cb_ + 6) fox_cumsum(a, (int)blockIdx.x - cb_, lds); }
            { pg8::Gemm g{PROJ + C_MQ, (const bf16_t*)(ws + WS_WQUP + l * SZ_WQUP), SEQ, NQUPP, 512, NINP}; pg8::StaticOrder S; S.init(SEQ, NQUPP, G, (int)blockIdx.x);
              pg8::EpiScaleBf16<false> E{QC, NQUPP, nullptr};
              pg8::gemm_phase<pg8::EpiScaleBf16<false>, pg8::StaticOrder, true, true>(lds, g, S, E); }
            { pg8::Gemm g{PROJ + C_CKV, (const bf16_t*)(ws + WS_WKVUP + l * SZ_WKVUP), SEQ, NKVUP, 256, NINP}; pg8::StaticOrder S; S.init(SEQ, NKVUP, G, (int)((blockIdx.x + 128) % G));
              pg8::EpiScaleBf16<false> E{KVC, NKVUP, nullptr};
              pg8::gemm_phase<pg8::EpiScaleBf16<false>, pg8::StaticOrder, true, true>(lds, g, S, E); }
        } else if (sp == 3 && (PHM & 16)) {
            for (int m = gw; m < SEQ; m += NGW) post_mla_row(a, l, m, lane);
        } else if (sp == 4 && (PHM & 32)) {
            attention_phase<0>(a, l, lds, 0);
#if DUP & 1
            { XcdBarrier b2; b2.bar = (unsigned*)(a->ws + WS_BAR); b2.x = xb_xcc_id(); b2.st = bst; xcd_barrier(b2); } attention_phase<AV>(a, l, lds, 2);
#endif
        } else if (sp == 5 && (PHM & 64)) {
            pg8::Gemm g{MIX, (const bf16_t*)(ws + WS_WOUT + l * SZ_WOUT), SEQ, DM, DM, DM}; pg8::StaticOrder S; S.init(SEQ, DM, G, (int)blockIdx.x);
            pg8::EpiResid E{l == 0 ? a->in[I_X] : (const float*)XF, XF, XB, SSQ + (2 * l + 1) * SEQ};
            pg8::gemm_phase<pg8::EpiResid, pg8::StaticOrder, true, true>(lds, g, S, E);
        } else if (sp == 6 && (PHM & 128)) {
            pg8::Gemm g{XB, (const bf16_t*)(ws + WS_WUP + l * SZ_WUP), SEQ, DFF, DM, DM}; pg8::StaticOrder S; S.init(SEQ, DFF, G, (int)blockIdx.x);
            pg8::EpiScaleBf16<true> E{HB, DFF, SSQ + (2 * l + 1) * SEQ};
            pg8::gemm_phase<pg8::EpiScaleBf16<true>, pg8::StaticOrder, true, true>(lds, g, S, E);
#if DUP & 4
            { XcdBarrier b2; b2.bar = (unsigned*)(a->ws + WS_BAR); b2.x = xb_xcc_id(); b2.st = bst; xcd_barrier(b2); } pg8::gemm_phase<pg8::EpiScaleBf16<true>, pg8::StaticOrder, true, true>(lds, g, S, E);
#endif
        } else if (sp == 7 && (PHM & 256)) {
            pg8::Gemm g{HB, (const bf16_t*)(ws + WS_WDN + l * SZ_WDN), SEQ, DM, DFF, DFF}; pg8::StaticOrder S; S.init(SEQ, DM, G, (int)blockIdx.x);
            pg8::EpiResid E{XF, l == 1 ? a->out : XF, l == 1 ? nullptr : XB, l == 1 ? nullptr : SSQ + 2 * SEQ};
            pg8::gemm_phase<pg8::EpiResid, pg8::StaticOrder, true, true>(lds, g, S, E);
        }
        if (ph + 1 < ph_hi) { XcdBarrier b2; b2.bar = (unsigned*)(a->ws + WS_BAR); b2.x = xb_xcc_id(); b2.st = bst; xcd_barrier(b2); }
    }
}

#ifndef ONE_LAUNCH
#define ONE_LAUNCH 1
#endif
extern "C" void kernel_launch(void* const* d_in, const int* in_sizes, int n_in, void* d_out, int out_size, void* d_ws, size_t ws_size, hipStream_t stream) {
    static int grid = 0;
    if (grid == 0) {
        if (n_in != 23 || out_size != SEQ * DM || ws_size < WS_END + 32 * MiB) { fprintf(stderr, "kernel_launch: unexpected shapes (n_in %d out %d ws %zu)\n", n_in, out_size, ws_size); grid = -1; return; }
        int dev = 0, cus = 0, per_cu = 0;
        (void)hipGetDevice(&dev); (void)hipDeviceGetAttribute(&cus, hipDeviceAttributeMultiprocessorCount, dev);
        if (hipFuncSetAttribute((const void*)fwd_kernel, hipFuncAttributeMaxDynamicSharedMemorySize, LDS_BYTES) != hipSuccess) { fprintf(stderr, "kernel_launch: hipFuncSetAttribute failed\n"); grid = -1; return; }
        if (hipOccupancyMaxActiveBlocksPerMultiprocessor(&per_cu, (const void*)fwd_kernel, 512, LDS_BYTES) != hipSuccess || per_cu < 1) { fprintf(stderr, "kernel_launch: occupancy query says %d\n", per_cu); per_cu = 1; }
        (void)hipGetLastError();
        if (cus <= 0) cus = 256;
        grid = cus;
    }
    if (grid < 0) return;
    if (hipMemsetAsync((char*)d_ws + WS_BAR, 0, XCD_BAR_WORDS * 4, stream) != hipSuccess) { fprintf(stderr, "kernel_launch: hipMemsetAsync failed\n"); return; }
    Args a{};
    for (int i = 0; i < 23; ++i) a.in[i] = (const float*)d_in[i];
    a.out = (float*)d_out; a.ws = (unsigned char*)d_ws;
#if ONE_LAUNCH
    a.ph_lo = 0; a.ph_hi = N_PHASES;
    { void* args[] = {&a};
      hipError_t e = hipLaunchCooperativeKernel((const void*)fwd_kernel, dim3(grid), dim3(512), args, LDS_BYTES, stream);
      if (e != hipSuccess) fprintf(stderr, "cooperative launch failed: %s (grid %d)\n", hipGetErrorString(e), grid); }
#else
    for (int ph = 0; ph < N_PHASES; ++ph) {
        a.ph_lo = ph; a.ph_hi = ph + 1;
        void* args[] = {&a};
        hipError_t e = hipLaunchCooperativeKernel((const void*)fwd_kernel, dim3(grid), dim3(512), args, LDS_BYTES, stream);
        if (e != hipSuccess) { fprintf(stderr, "cooperative launch %d failed: %s (grid %d)\n", ph, hipGetErrorString(e), grid); break; }
    }
#endif
}
```
